# Optimizing an MI355X kernel written in HIP

```python
import math
import jax, jax.numpy as jnp
from jax import lax
import numpy as np

D_MODEL = 1024
BATCH = 4
SEQ = 4096
DEPTH = 4

D_MIX = D_MODEL
LRU_WIDTH = D_MIX // 2
LRU_BLOCKS = 8
LRU_BLOCK_W = LRU_WIDTH // LRU_BLOCKS
LRU_C = 8.0
CONV_WIDTH = 4
CONV_PAD = (CONV_WIDTH // 2, CONV_WIDTH - 1 - CONV_WIDTH // 2)
N_HEADS = 8
N_KV_HEADS = 2
KV_GROUP = N_HEADS // N_KV_HEADS
HEAD_DIM = (D_MIX - LRU_WIDTH) // N_HEADS
ATT_WIDTH = N_HEADS * HEAD_DIM
KV_WIDTH = N_KV_HEADS * HEAD_DIM
WINDOW = 128
BLOCK = 128
N_BUCKETS = 32
MAX_DISTANCE = 128
D_FF = ((8 * D_MODEL // 3 + 255) // 256) * 256
FFN_RES = 0.5
EPS = 1e-6
NEG_INF = -1e30
D_IN = 2 * LRU_WIDTH + ATT_WIDTH + 2 * KV_WIDTH
SPLITS = (LRU_WIDTH, 2 * LRU_WIDTH, 2 * LRU_WIDTH + ATT_WIDTH, 2 * LRU_WIDTH + ATT_WIDTH + KV_WIDTH)

kernel_name = 'hymba_style_rglru_swa_macaron_encoder'


def rms_norm(x, g):
    x32 = x.astype(jnp.float32)
    y = x32 * lax.rsqrt(jnp.mean(x32 * x32, axis=-1, keepdims=True) + EPS)
    return (y * g.astype(jnp.float32)).astype(x.dtype)


def swiglu(x, w_gate, w_up, w_down):
    return (jax.nn.silu(x @ w_gate) * (x @ w_up)) @ w_down


def t5_buckets(rel):
    half = N_BUCKETS // 2
    max_exact = half // 2
    ret = (rel > 0).astype(jnp.int32) * half
    n = jnp.abs(rel)
    n_f = jnp.maximum(n, 1).astype(jnp.float32)
    large = max_exact + (jnp.log(n_f / max_exact) / math.log(MAX_DISTANCE / max_exact) * (half - max_exact)).astype(jnp.int32)
    large = jnp.minimum(large, half - 1)
    return ret + jnp.where(n < max_exact, n, large)


def band_layout(seq):
    nb = seq // BLOCK
    n_idx = jnp.arange(nb)[:, None, None]
    t = jnp.arange(BLOCK)[None, :, None]
    j = jnp.arange(3 * BLOCK)[None, None, :]
    rel = j - BLOCK - t
    key_pos = (n_idx - 1) * BLOCK + j
    mask = (jnp.abs(rel) <= WINDOW) & (key_pos >= 0) & (key_pos < seq)
    return t5_buckets(rel[0]), mask


def band_windows(t, nb):
    b = t.shape[0]
    tp = jnp.pad(t, ((0, 0), (BLOCK, BLOCK), (0, 0), (0, 0)))
    tb = tp.reshape(b, nb + 2, BLOCK, N_KV_HEADS, HEAD_DIM)
    return jnp.concatenate([tb[:, :-2], tb[:, 1:-1], tb[:, 2:]], axis=2)


def windowed_gqa(q, k, v, sink, rel_bias):
    b, s = q.shape[0], q.shape[1]
    nb = s // BLOCK
    qb = q.reshape(b, nb, BLOCK, N_KV_HEADS, KV_GROUP, HEAD_DIM) * (HEAD_DIM ** -0.5)
    kw = band_windows(k.reshape(b, s, N_KV_HEADS, HEAD_DIM), nb)
    vw = band_windows(v.reshape(b, s, N_KV_HEADS, HEAD_DIM), nb)
    buckets, mask = band_layout(s)
    bias = rel_bias[buckets].astype(jnp.float32)
    bias = jnp.transpose(bias, (2, 0, 1)).reshape(N_KV_HEADS, KV_GROUP, BLOCK, 3 * BLOCK)
    logits = jnp.einsum('bnqkgd,bnjkd->bnkgqj', qb, kw).astype(jnp.float32) + bias
    logits = jnp.where(mask[None, :, None, None], logits, NEG_INF)
    sink32 = sink.astype(jnp.float32).reshape(1, 1, N_KV_HEADS, KV_GROUP, 1, 1)
    m = jnp.maximum(jnp.max(logits, axis=-1, keepdims=True), sink32)
    p = jnp.exp(logits - m)
    p = p / (jnp.sum(p, axis=-1, keepdims=True) + jnp.exp(sink32 - m))
    o = jnp.einsum('bnkgqj,bnjkd->bnqkgd', p.astype(vw.dtype), vw)
    return o.reshape(b, s, ATT_WIDTH)


def _linear_combine(left, right):
    a_l, b_l = left
    a_r, b_r = right
    return a_l * a_r, a_r * b_l + b_r


def rg_lru_direction(xc, w_a, b_a, w_x, b_x, lam, reverse):
    b, s = xc.shape[0], xc.shape[1]
    xb = xc.reshape(b, s, LRU_BLOCKS, LRU_BLOCK_W)
    r = jax.nn.sigmoid(jnp.einsum('bsnc,ncd->bsnd', xb, w_a).reshape(b, s, LRU_WIDTH).astype(jnp.float32) + b_a.astype(jnp.float32))
    i = jax.nn.sigmoid(jnp.einsum('bsnc,ncd->bsnd', xb, w_x).reshape(b, s, LRU_WIDTH).astype(jnp.float32) + b_x.astype(jnp.float32))
    log_a = -LRU_C * jax.nn.softplus(-lam.astype(jnp.float32)) * r
    a = jnp.exp(log_a)
    u = jnp.sqrt(-jnp.expm1(2.0 * log_a)) * (i * xc.astype(jnp.float32))
    _, h = lax.associative_scan(_linear_combine, (a, u), axis=1, reverse=reverse)
    return h


def recurrent_group(xr, gate, conv_w, conv_b, w_a, b_a, w_x, b_x, lam):
    xc = lax.conv_general_dilated(xr, conv_w[:, None, :], window_strides=(1,), padding=[CONV_PAD],
                                  dimension_numbers=('NWC', 'WIO', 'NWC'), feature_group_count=LRU_WIDTH) + conv_b
    h = (rg_lru_direction(xc, w_a[0], b_a[0], w_x[0], b_x[0], lam[0], False)
         + rg_lru_direction(xc, w_a[1], b_a[1], w_x[1], b_x[1], lam[1], True))
    return (jax.nn.gelu(gate.astype(jnp.float32)) * h).astype(xr.dtype)


def setup_inputs(seed: int = 0) -> dict:
    key = jax.random.key(seed)
    ks = jax.random.split(key, 32)
    f32 = jnp.float32

    def nrm(k, shape, fan_in):
        return jax.random.normal(k, shape, f32) * (fan_in ** -0.5)

    def gain(k, shape):
        return 1.0 + 0.02 * jax.random.normal(k, shape, f32)

    def small(k, shape, scale=0.01):
        return scale * jax.random.normal(k, shape, f32)

    u = jax.random.uniform(ks[14], (DEPTH, 2, LRU_WIDTH), f32, minval=0.9, maxval=0.999)
    a0 = u ** (1.0 / LRU_C)
    lru_lambda = jnp.log(a0) - jnp.log1p(-a0)
    return {
        'x': jax.random.normal(ks[0], (BATCH, SEQ, D_MODEL), f32),
        'ffn1_norm': gain(ks[1], (DEPTH, D_MODEL)),
        'ffn1_w_gate': nrm(ks[2], (DEPTH, D_MODEL, D_FF), D_MODEL),
        'ffn1_w_up': nrm(ks[3], (DEPTH, D_MODEL, D_FF), D_MODEL),
        'ffn1_w_down': nrm(ks[4], (DEPTH, D_FF, D_MODEL), D_FF),
        'mix_norm': gain(ks[5], (DEPTH, D_MODEL)),
        'w_in': nrm(ks[6], (DEPTH, D_MODEL, D_IN), D_MODEL),
        'conv_w': nrm(ks[7], (DEPTH, CONV_WIDTH, LRU_WIDTH), CONV_WIDTH),
        'conv_b': small(ks[8], (DEPTH, LRU_WIDTH)),
        'lru_w_a': nrm(ks[9], (DEPTH, 2, LRU_BLOCKS, LRU_BLOCK_W, LRU_BLOCK_W), LRU_BLOCK_W),
        'lru_b_a': small(ks[10], (DEPTH, 2, LRU_WIDTH), 0.1),
        'lru_w_x': nrm(ks[11], (DEPTH, 2, LRU_BLOCKS, LRU_BLOCK_W, LRU_BLOCK_W), LRU_BLOCK_W),
        'lru_b_x': small(ks[12], (DEPTH, 2, LRU_WIDTH), 0.1),
        'lru_lambda': lru_lambda,
        'attn_sink': 0.5 * jax.random.normal(ks[15], (DEPTH, N_HEADS), f32),
        'rel_bias': 0.2 * jax.random.normal(ks[16], (N_BUCKETS, N_HEADS), f32),
        'lru_out_norm': gain(ks[17], (DEPTH, LRU_WIDTH)),
        'attn_out_norm': gain(ks[18], (DEPTH, ATT_WIDTH)),
        'w_out': nrm(ks[19], (DEPTH, D_MIX, D_MODEL), D_MIX),
        'ffn2_norm': gain(ks[20], (DEPTH, D_MODEL)),
        'ffn2_w_gate': nrm(ks[21], (DEPTH, D_MODEL, D_FF), D_MODEL),
        'ffn2_w_up': nrm(ks[22], (DEPTH, D_MODEL, D_FF), D_MODEL),
        'ffn2_w_down': nrm(ks[23], (DEPTH, D_FF, D_MODEL), D_FF),
        'final_norm': gain(ks[24], (D_MODEL,)),
    }


def reference(x, ffn1_norm, ffn1_w_gate, ffn1_w_up, ffn1_w_down, mix_norm, w_in, conv_w, conv_b,
              lru_w_a, lru_b_a, lru_w_x, lru_b_x, lru_lambda, attn_sink, rel_bias,
              lru_out_norm, attn_out_norm, w_out, ffn2_norm, ffn2_w_gate, ffn2_w_up, ffn2_w_down,
              final_norm):
    for l in range(DEPTH):
        x = x + FFN_RES * swiglu(rms_norm(x, ffn1_norm[l]), ffn1_w_gate[l], ffn1_w_up[l], ffn1_w_down[l])
        h = rms_norm(x, mix_norm[l])
        proj = h @ w_in[l]
        xr, gate, q, k, v = jnp.split(proj, SPLITS, axis=-1)
        y_rec = recurrent_group(xr, gate, conv_w[l], conv_b[l], lru_w_a[l], lru_b_a[l],
                                lru_w_x[l], lru_b_x[l], lru_lambda[l])
        y_att = windowed_gqa(q, k, v, attn_sink[l], rel_bias)
        y = jnp.concatenate([rms_norm(y_rec, lru_out_norm[l]), rms_norm(y_att, attn_out_norm[l])], axis=-1)
        x = x + y @ w_out[l]
        x = x + FFN_RES * swiglu(rms_norm(x, ffn2_norm[l]), ffn2_w_gate[l], ffn2_w_up[l], ffn2_w_down[l])
    return rms_norm(x, final_norm)
```

```cpp
#include <hip/hip_runtime.h>
#include <hip/hip_cooperative_groups.h>
#include <cstdio>
#include <cstdint>
namespace cg = cooperative_groups;
#define PROBE_MIXREP 1
#define PROBE_SYNCREP 1
#define PROBE_PROREP 1
#define PROBE_ATTNREP 1
#define PROBE_D1REP 1
#define PROBE_D2REP 1
#define PROBE_GUREP 1
#define PROBE_NOTAIL 0
namespace pg8 {
#define PG8_LAS __attribute__((address_space(3)))
typedef unsigned short bf16_t;
typedef short bf16x8 __attribute__((ext_vector_type(8)));
typedef float f32x4 __attribute__((ext_vector_type(4)));
typedef unsigned u32x4 __attribute__((ext_vector_type(4)));
constexpr int BM = 256, BK = 64, HALF = 128, HTB = HALF * BK * 2  , STAGE_BYTES = 8 * HTB, NXCD = 8, WGM = 8;

__host__ __device__ __forceinline__ int lds_byte(int r, int c) { const int st = (r >> 4) * 2 + (c >> 5), rr = r & 15, cc = c & 31, ob = rr * 64 + cc * 2; return st * 1024 + (ob ^ (((ob >> 9) & 1) << 5)); }
__host__ __device__ __forceinline__ void stage_rc(int b, int& R, int& C) { const int st = b / 1024, sb = b % 1024, swz = sb ^ (((sb >> 9) & 1) << 5); R = (st >> 1) * 16 + swz / 64; C = (st & 1) * 32 + (swz % 64) / 2; }
__host__ __device__ __forceinline__ int perm32(int rho) { const int n = rho >> 4, i = rho & 15; return 8 * (i >> 2) + 4 * n + (i & 3); }

struct Unit { int pm, pn; };
struct Gemm { const bf16_t* A; const bf16_t* Bt; int M, N, K; };

struct StaticOrder {
    int nM, nN, nwg, G, c;
    __host__ __device__ void init(int M, int N, int G_, int c_) { nM = M / BM; nN = N / BM; nwg = nM * nN; G = G_; c = c_; }
    __host__ __device__ bool next(int i, Unit& u) const {
        const long L = (long)i * G + c; if (L >= nwg) return false;
        int wgid = (int)L; { const int q = nwg / NXCD, r = nwg % NXCD, xcd = wgid % NXCD, off = wgid / NXCD; wgid = (xcd < r ? xcd * (q + 1) : r * (q + 1) + (xcd - r) * q) + off; }
        const int nig = WGM * nN, gid = wgid / nig, fm = gid * WGM, gsz = (nM - fm) < WGM ? (nM - fm) : WGM;
        u.pm = fm + ((wgid % nig) % gsz); u.pn = (wgid % nig) / gsz; return true;
    }
    __device__ __forceinline__ void a_ready(const Unit&) const {}
    __device__ __forceinline__ void done(const Unit&) const {}
};

__device__ __forceinline__ unsigned cvt_pk_bf16(float lo, float hi) { unsigned r; asm volatile("v_cvt_pk_bf16_f32 %0, %1, %2" : "=v"(r) : "v"(lo), "v"(hi)); return r; }
template <class Epi, class Sched, bool ALIGN_EPI = false, bool SP2 = false>
__device__ __forceinline__ void gemm_phase(PG8_LAS unsigned char* lds, const Gemm g, const Sched& S, const Epi& E) {
    int tid_ = threadIdx.x; asm volatile("" : "+v"(tid_));
    const int tid = tid_, wid = __builtin_amdgcn_readfirstlane(tid >> 6), lane = tid & 63, wr = wid >> 2, wc = wid & 3, fr = lane & 15, fq = lane >> 4;
    const int K = g.K, nt = K / BK;
    unsigned voffA[2], voffB[2];
#pragma unroll
    for (int i = 0; i < 2; ++i) { int R, C; stage_rc(tid * 16 + i * 8192, R, C); const int Rb = Epi::PERM ? ((R & ~31) + perm32(R & 31)) : R;
        voffA[i] = (unsigned)(R * K + C) * 2u; voffB[i] = (unsigned)(Rb * K + C) * 2u; }
    const size_t kstep = (size_t)(BK * 2);
    const size_t hstep = (size_t)HALF * K * 2;
    const size_t tstep = 2 * hstep;
    const unsigned ldsw = (unsigned)wid * 1024u;
    const int aoff = lds_byte(wr * 64 + fr, fq * 8), boff = lds_byte(wc * 32 + fr, fq * 8);
#define PG8_SA(b, h) (((b) * 2 + (h)) * HTB)
#define PG8_SB(b, h) ((4 + (b) * 2 + (h)) * HTB)
#define PG8_STAGE(bufoff, gbase, voff) do { _Pragma("unroll") for (int _i = 0; _i < 2; ++_i) \
        __builtin_amdgcn_global_load_lds((const unsigned*)((const char*)(gbase) + (voff)[_i]), (PG8_LAS unsigned*)(lds + (bufoff) + ldsw + _i * 8192), 16, 0, 0); } while (0)
#define PG8_LDA(dst, b, h) do { _Pragma("unroll") for (int m = 0; m < 4; ++m) _Pragma("unroll") for (int k = 0; k < 2; ++k) dst[m][k] = *(const PG8_LAS bf16x8*)(lds + PG8_SA(b, h) + aoff + m * 2048 + k * 1024); } while (0)
#define PG8_LDB(dst, b, h) do { _Pragma("unroll") for (int n = 0; n < 2; ++n) _Pragma("unroll") for (int k = 0; k < 2; ++k) dst[n][k] = *(const PG8_LAS bf16x8*)(lds + PG8_SB(b, h) + boff + n * 2048 + k * 1024); } while (0)
#define PG8_MMA(ai, bj, At, Bt) do { __builtin_amdgcn_s_setprio(1); _Pragma("unroll") for (int m = 0; m < 4; ++m) _Pragma("unroll") for (int n = 0; n < 2; ++n) _Pragma("unroll") for (int k = 0; k < 2; ++k) \
        acc[ai][bj][m][n] = __builtin_amdgcn_mfma_f32_16x16x32_bf16(Bt[n][k], At[m][k], acc[ai][bj][m][n], 0, 0, 0); __builtin_amdgcn_s_setprio(0); } while (0)
#define PG8_WAIT_V(n) asm volatile("s_waitcnt vmcnt(" #n ")" ::: "memory")
#define PG8_WAIT_L(n) asm volatile("s_waitcnt lgkmcnt(" #n ")" ::: "memory")
#define PG8_BAR __builtin_amdgcn_s_barrier()
#define PG8_SCHED __builtin_amdgcn_sched_barrier(0)
    Unit cur, nxt; int ui = 0;
    if (!S.next(0, cur)) return;
    f32x4 acc[2][2][4][2];
#pragma unroll
    for (int a = 0; a < 2; ++a)
#pragma unroll
        for (int b = 0; b < 2; ++b)
#pragma unroll
            for (int m = 0; m < 4; ++m)
#pragma unroll
                for (int n = 0; n < 2; ++n) acc[a][b][m][n] = (f32x4){0.f, 0.f, 0.f, 0.f};
    bf16x8 At[4][2], B0[2][2], B1[2][2];
    const char* cA = (const char*)g.A + (size_t)cur.pm * tstep; const char* cB = (const char*)g.Bt + (size_t)cur.pn * tstep;
    S.a_ready(cur);
    if constexpr (SP2) {
        PG8_STAGE(PG8_SB(0, 0), cB, voffB); PG8_STAGE(PG8_SB(0, 1), cB + hstep, voffB); PG8_STAGE(PG8_SA(0, 0), cA, voffA); PG8_STAGE(PG8_SA(0, 1), cA + hstep, voffA);
        if (wr == 1) PG8_BAR;
        PG8_WAIT_V(2); PG8_BAR;
        PG8_STAGE(PG8_SB(1, 0), cB + kstep, voffB); PG8_STAGE(PG8_SA(1, 0), cA + kstep, voffA); PG8_STAGE(PG8_SB(1, 1), cB + hstep + kstep, voffB);
        PG8_WAIT_V(6); PG8_BAR;
    } else {
        PG8_STAGE(PG8_SB(0, 0), cB, voffB); PG8_STAGE(PG8_SA(0, 0), cA, voffA); PG8_STAGE(PG8_SB(0, 1), cB + hstep, voffB); PG8_STAGE(PG8_SA(0, 1), cA + hstep, voffA);
        if (wr == 1) PG8_BAR;
        PG8_WAIT_V(4); PG8_BAR;
        PG8_STAGE(PG8_SB(1, 0), cB + kstep, voffB); PG8_STAGE(PG8_SA(1, 0), cA + kstep, voffA); PG8_STAGE(PG8_SB(1, 1), cB + hstep + kstep, voffB);
        PG8_WAIT_V(6); PG8_BAR;
    }
    for (;;) {
        const bool has_next = S.next(ui + 1, nxt);
        const char* nA = has_next ? (const char*)g.A + (size_t)nxt.pm * tstep : cA; const char* nB = has_next ? (const char*)g.Bt + (size_t)nxt.pn * tstep : cB;
        for (int t = 0; t < nt; t += 2) {
            const bool last = (t == nt - 2);
            const char* a1 = cA + (size_t)(t + 1) * kstep;
            const char* a2 = last ? nA : cA + (size_t)(t + 2) * kstep; const char* b2 = last ? nB : cB + (size_t)(t + 2) * kstep;
            const char* a3 = a2 + kstep; const char* b3 = b2 + kstep;
            if (last && has_next) S.a_ready(nxt);
            if constexpr (SP2) {
            PG8_LDB(B0, 0, 0); PG8_LDB(B1, 0, 1); PG8_SCHED; PG8_LDA(At, 0, 0); PG8_STAGE(PG8_SA(1, 1), a1 + hstep, voffA);
            PG8_WAIT_V(8); PG8_WAIT_L(0); PG8_BAR; PG8_MMA(0, 0, At, B0); PG8_MMA(0, 1, At, B1); PG8_BAR; PG8_SCHED;
            PG8_LDA(At, 0, 1); PG8_STAGE(PG8_SB(0, 0), b2, voffB); PG8_STAGE(PG8_SB(0, 1), b2 + hstep, voffB); PG8_STAGE(PG8_SA(0, 0), a2, voffA);
            PG8_WAIT_V(8); PG8_WAIT_L(0); PG8_BAR; PG8_MMA(1, 0, At, B0); PG8_MMA(1, 1, At, B1); PG8_BAR; PG8_SCHED;
            PG8_LDB(B0, 1, 0); PG8_LDB(B1, 1, 1); PG8_SCHED; PG8_LDA(At, 1, 0); PG8_STAGE(PG8_SA(0, 1), a2 + hstep, voffA);
            PG8_WAIT_V(8); PG8_WAIT_L(0); PG8_BAR; PG8_MMA(0, 0, At, B0); PG8_MMA(0, 1, At, B1); PG8_BAR; PG8_SCHED;
            PG8_LDA(At, 1, 1); PG8_STAGE(PG8_SB(1, 0), b3, voffB); PG8_STAGE(PG8_SB(1, 1), b3 + hstep, voffB); PG8_STAGE(PG8_SA(1, 0), a3, voffA);
            PG8_WAIT_V(8); PG8_WAIT_L(0); PG8_BAR; PG8_MMA(1, 0, At, B0); PG8_MMA(1, 1, At, B1); PG8_BAR; PG8_SCHED;
            } else {
            PG8_LDB(B0, 0, 0); PG8_SCHED; PG8_LDA(At, 0, 0); PG8_STAGE(PG8_SA(1, 1), a1 + hstep, voffA);
            PG8_WAIT_L(8); PG8_BAR; PG8_WAIT_L(0); PG8_MMA(0, 0, At, B0); PG8_BAR; PG8_SCHED;
            PG8_LDB(B1, 0, 1); PG8_STAGE(PG8_SB(0, 0), b2, voffB);
            PG8_BAR; PG8_WAIT_L(0); PG8_MMA(0, 1, At, B1); PG8_BAR;
            PG8_LDA(At, 0, 1); PG8_STAGE(PG8_SA(0, 0), a2, voffA);
            PG8_BAR; PG8_WAIT_L(0); PG8_MMA(1, 0, At, B0); PG8_BAR; PG8_SCHED;
            PG8_STAGE(PG8_SB(0, 1), b2 + hstep, voffB);
            PG8_WAIT_V(6); PG8_BAR; PG8_MMA(1, 1, At, B1); PG8_BAR;
            PG8_LDB(B0, 1, 0); PG8_SCHED; PG8_LDA(At, 1, 0); PG8_STAGE(PG8_SA(0, 1), a2 + hstep, voffA);
            PG8_WAIT_L(8); PG8_BAR; PG8_WAIT_L(0); PG8_MMA(0, 0, At, B0); PG8_BAR; PG8_SCHED;
            PG8_LDB(B1, 1, 1); PG8_STAGE(PG8_SB(1, 0), b3, voffB);
            PG8_BAR; PG8_WAIT_L(0); PG8_MMA(0, 1, At, B1); PG8_BAR;
            PG8_LDA(At, 1, 1); PG8_STAGE(PG8_SA(1, 0), a3, voffA);
            PG8_BAR; PG8_WAIT_L(0); PG8_MMA(1, 0, At, B0); PG8_BAR; PG8_SCHED;
            PG8_STAGE(PG8_SB(1, 1), b3 + hstep, voffB);
            PG8_WAIT_V(6); PG8_BAR; PG8_MMA(1, 1, At, B1); PG8_BAR;
            }
        }
        if constexpr (ALIGN_EPI) { if (wr == 0) PG8_BAR; }
        if constexpr (!Epi::AFTER_DRAIN) { E(acc, cur, wr, wc, fr, fq); S.done(cur); }
        if (!has_next) break;
#pragma unroll
        for (int a = 0; a < 2; ++a)
#pragma unroll
            for (int b = 0; b < 2; ++b)
#pragma unroll
                for (int m = 0; m < 4; ++m)
#pragma unroll
                    for (int n = 0; n < 2; ++n) acc[a][b][m][n] = (f32x4){0.f, 0.f, 0.f, 0.f};
        cur = nxt; cA = nA; cB = nB; ++ui;
        if constexpr (ALIGN_EPI) { if (wr == 1) PG8_BAR; }
    }
    PG8_WAIT_V(0);
    if constexpr (!ALIGN_EPI) { if (wr == 0) PG8_BAR; }
    PG8_BAR;
    if constexpr (Epi::AFTER_DRAIN) { E.fused(acc, cur, wr, wc, fr, fq, lds, wid, lane); S.done(cur); }
#undef PG8_SA
#undef PG8_SB
#undef PG8_STAGE
#undef PG8_LDA
#undef PG8_LDB
#undef PG8_MMA
#undef PG8_WAIT_V
#undef PG8_WAIT_L
#undef PG8_BAR
#undef PG8_SCHED
}
}

namespace pg8 {
typedef float f32x2 __attribute__((ext_vector_type(2)));
__device__ __forceinline__ void rows_rstd(const float* ss, int row0, float (&rs)[2][4]) {
    f32x4 p[2][4];
#pragma unroll
    for (int ai = 0; ai < 2; ++ai)
#pragma unroll
        for (int m = 0; m < 4; ++m) p[ai][m] = *(const f32x4*)(ss + (size_t)(row0 + ai * HALF + m * 16) * 4);
    asm volatile("" ::: "memory");
#pragma unroll
    for (int ai = 0; ai < 2; ++ai)
#pragma unroll
        for (int m = 0; m < 4; ++m) rs[ai][m] = __builtin_amdgcn_rsqf(((p[ai][m].x + p[ai][m].y) + (p[ai][m].z + p[ai][m].w)) * (1.f / 1024.f) + 1e-6f);
}

struct EpiSwiglu {
    static constexpr bool PERM = true, AFTER_DRAIN = false;
    bf16_t* H; const float* ss;
    __device__ __forceinline__ void operator()(const f32x4 (&acc)[2][2][4][2], const Unit& u, int wr, int wc, int fr, int fq) const {
        const int row0 = u.pm * BM + wr * 64 + fr, col0 = u.pn * 128 + wc * 32 + 8 * fq;
        float rsv[2][4]; rows_rstd(ss, row0, rsv);
#pragma unroll
        for (int ai = 0; ai < 2; ++ai)
#pragma unroll
            for (int m = 0; m < 4; ++m) {
                const int row = row0 + ai * HALF + m * 16; const float rs = rsv[ai][m], c1 = rs * -1.4426950408889634f, rs2 = rs * rs;
                u32x4 w;
#pragma unroll
                for (int q = 0; q < 4; ++q) {
                    const f32x4 G4 = acc[ai][0][m][q >> 1], U4 = acc[ai][1][m][q >> 1];
                    const f32x2 G = (q & 1) ? (f32x2){G4.z, G4.w} : (f32x2){G4.x, G4.y}, U = (q & 1) ? (f32x2){U4.z, U4.w} : (f32x2){U4.x, U4.y}, t = G * c1;
                    f32x2 e; e.x = __builtin_amdgcn_exp2f(t.x); e.y = __builtin_amdgcn_exp2f(t.y);
                    const f32x2 d = e + 1.f;
                    f32x2 r; r.x = __builtin_amdgcn_rcpf(d.x); r.y = __builtin_amdgcn_rcpf(d.y);
                    const f32x2 o = (G * U) * (r * rs2);
                    const unsigned pk = cvt_pk_bf16(o.x, o.y);
                    if (q == 0) w.x = pk; else if (q == 1) w.y = pk; else if (q == 2) w.z = pk; else w.w = pk; }
                *(u32x4*)(H + (size_t)row * 2816 + col0) = w; }
    }
};
struct EpiRes {
    static constexpr bool PERM = true, AFTER_DRAIN = false;
    const float* Xin; float* X; bf16_t* XB; float* ss; float scale; PG8_LAS float* red;
    __device__ __forceinline__ void operator()(const f32x4 (&acc)[2][2][4][2], const Unit& u, int wr, int wc, int fr, int fq) const {
        const int row0 = u.pm * BM + wr * 64 + fr, col0 = u.pn * BM + wc * 32 + 8 * fq;
#pragma unroll
        for (int ai = 0; ai < 2; ++ai) {
            f32x4 xv[4][2][2];
#pragma unroll
            for (int m = 0; m < 4; ++m)
#pragma unroll
                for (int bj = 0; bj < 2; ++bj) { const float* xp = Xin + (size_t)(row0 + ai * HALF + m * 16) * 1024 + col0 + bj * HALF;
                    xv[m][bj][0] = *(const f32x4*)xp; xv[m][bj][1] = *(const f32x4*)(xp + 4); }
            asm volatile("" ::: "memory");
#pragma unroll
            for (int m = 0; m < 4; ++m) {
                const int row = row0 + ai * HALF + m * 16; float sq = 0.f;
#pragma unroll
                for (int bj = 0; bj < 2; ++bj) {
                    float* xp = X + (size_t)row * 1024 + col0 + bj * HALF;
                    const f32x4 x0 = xv[m][bj][0] + acc[ai][bj][m][0] * scale, x1 = xv[m][bj][1] + acc[ai][bj][m][1] * scale;
                    *(f32x4*)xp = x0; *(f32x4*)(xp + 4) = x1;
                    u32x4 w; w.x = cvt_pk_bf16(x0[0], x0[1]); w.y = cvt_pk_bf16(x0[2], x0[3]); w.z = cvt_pk_bf16(x1[0], x1[1]); w.w = cvt_pk_bf16(x1[2], x1[3]);
                    *(u32x4*)(XB + (size_t)row * 1024 + col0 + bj * HALF) = w;
                    sq += (x0[0] * x0[0] + x0[1] * x0[1]) + (x0[2] * x0[2] + x0[3] * x0[3]) + (x1[0] * x1[0] + x1[1] * x1[1]) + (x1[2] * x1[2] + x1[3] * x1[3]); }
                sq += __shfl_xor(sq, 16); sq += __shfl_xor(sq, 32);
                if (fq == 0) red[(wr * 64 + fr + ai * HALF + m * 16) * 4 + wc] = sq; }
        }
        asm volatile("s_waitcnt lgkmcnt(0)" ::: "memory"); __builtin_amdgcn_s_barrier();
        { const int t = threadIdx.x; if (t < 256) { const f32x4 p = *(const PG8_LAS f32x4*)(red + t * 4); ss[(size_t)(u.pm * BM + t) * 4 + u.pn] = (p.x + p.y) + (p.z + p.w); } }
        asm volatile("s_waitcnt lgkmcnt(0)" ::: "memory"); __builtin_amdgcn_s_barrier();
    }
};
struct EpiProj {
    static constexpr bool PERM = true, AFTER_DRAIN = false;
    bf16_t* P; const float* ss;
    __device__ __forceinline__ void operator()(const f32x4 (&acc)[2][2][4][2], const Unit& u, int wr, int wc, int fr, int fq) const {
        const int row0 = u.pm * BM + wr * 64 + fr, col0 = u.pn * BM + wc * 32 + 8 * fq;
        float rsv[2][4]; rows_rstd(ss, row0, rsv);
#pragma unroll
        for (int ai = 0; ai < 2; ++ai)
#pragma unroll
            for (int m = 0; m < 4; ++m) {
                const int row = row0 + ai * HALF + m * 16; const float rs = rsv[ai][m];
#pragma unroll
                for (int bj = 0; bj < 2; ++bj) {
                    const f32x4 v0 = acc[ai][bj][m][0] * rs, v1 = acc[ai][bj][m][1] * rs;
                    u32x4 w; w.x = cvt_pk_bf16(v0[0], v0[1]); w.y = cvt_pk_bf16(v0[2], v0[3]); w.z = cvt_pk_bf16(v1[0], v1[1]); w.w = cvt_pk_bf16(v1[2], v1[3]);
                    *(u32x4*)(P + (size_t)row * 1792 + col0 + bj * HALF) = w; } }
    }
};
}

#define LAS __attribute__((address_space(3)))
typedef unsigned short bf16;
typedef short bf16x8 __attribute__((ext_vector_type(8)));
typedef float f32x4 __attribute__((ext_vector_type(4)));
typedef float f32x2 __attribute__((ext_vector_type(2)));
typedef float f32x16 __attribute__((ext_vector_type(16)));
typedef unsigned u32x4 __attribute__((ext_vector_type(4)));
typedef unsigned u32x2 __attribute__((ext_vector_type(2)));
#define MFMA32(a, b, c) __builtin_amdgcn_mfma_f32_32x32x16_bf16((a), (b), (c), 0, 0, 0)

constexpr int NB = 4, SEQ = 4096, T = NB * SEQ, D = 1024, FF = 2816, NGU = 2 * FF, DIN = 1792, DEPTH = 4, LW = 512;
constexpr int NCH = SEQ / 32;
constexpr int NWAVES = 8, NTHR = 512;
constexpr int LDS_BTAB = 131072 + 256 + 4096, LDS_RSTD = LDS_BTAB + 8 * 384 * 4, LDS_BYTES = LDS_RSTD + 2048;
constexpr size_t W_GU1 = 0, W_D1 = W_GU1 + (size_t)NGU * D, W_IN = W_D1 + (size_t)D * FF, W_OUT = W_IN + (size_t)DIN * D, W_GU2 = W_OUT + (size_t)D * D,
                 W_D2 = W_GU2 + (size_t)NGU * D, W_LRU = W_D2 + (size_t)D * FF, W_LAYER = W_LRU + 131072;
constexpr size_t MiB = 1u << 20;
constexpr size_t WS_W = 1 * MiB, WS_XB = 160 * MiB, WS_H = 192 * MiB, WS_PROJ = WS_H, WS_Y = WS_H + 56 * MiB, WS_SS = 280 * MiB, WS_TOT = 281 * MiB, WS_CAR = 285 * MiB, WS_HP = 287 * MiB, WS_END = 351 * MiB;
static_assert(WS_W + W_LAYER * 2 * DEPTH <= WS_XB && (size_t)T * FF * 2 <= 88 * MiB && (size_t)T * DIN * 2 <= 56 * MiB, "ws map");

struct Args { const float* in[24]; float* out; unsigned char* ws; int coop; int pad; };


__device__ __forceinline__ unsigned f2bf(float f) { unsigned u = __builtin_bit_cast(unsigned, f); return (u + 0x7fffu + ((u >> 16) & 1u)) >> 16; }
__device__ __forceinline__ unsigned pk2(float lo, float hi) { return f2bf(lo) | (f2bf(hi) << 16); }
__device__ __forceinline__ float bf2f(unsigned short b) { return __builtin_bit_cast(float, (unsigned)b << 16); }
__device__ __forceinline__ float wave_sum(float v) {
#pragma unroll
    for (int o = 1; o < 64; o <<= 1) v += __shfl_xor(v, o);
    return v;
}
#define LDS_WAVE_SYNC() asm volatile("s_waitcnt lgkmcnt(0)" ::: "memory")
__device__ __forceinline__ float sigmoid_f(float x) { return __builtin_amdgcn_rcpf(1.f + __expf(-x)); }
__device__ __forceinline__ float gelu_tanh(float x) {
    const float z = 0.7978845608028654f * (x + 0.044715f * x * x * x);
    const float e = __expf(2.f * z);
    const float th = 1.f - 2.f * __builtin_amdgcn_rcpf(e + 1.f);
    return 0.5f * x * (1.f + th);
}

template <bool HASG>
__device__ __forceinline__ void tr_item(const float* W, int K, int N, bf16* WT, int rowmode, const float* g, LAS float* scr, int item, int lane) {
    const int nblk = N / 32, kb = item / nblk, nb = item % nblk, k0 = 64 * kb, n0 = 32 * nb;
    const float* wp = W + (size_t)(k0 + (lane >> 5)) * N + n0 + (lane & 31);
    const int c = lane & 7;
    float v[32];
#pragma unroll
    for (int i = 0; i < 32; ++i) v[i] = wp[(size_t)(2 * i) * N];
    f32x4 g0 = (f32x4){1.f, 1.f, 1.f, 1.f}, g1 = g0;
    if (HASG) { g0 = *(const f32x4*)(g + k0 + 8 * c); g1 = *(const f32x4*)(g + k0 + 8 * c + 4); }
    asm volatile("" ::: "memory");
#pragma unroll
    for (int i = 0; i < 32; ++i) scr[(2 * i + (lane >> 5)) * 33 + (lane & 31)] = v[i];
    LDS_WAVE_SYNC();
    const int drow0 = rowmode == 0 ? n0 : ((n0 >> 7) * 256 + (n0 & 127) + (rowmode == 2 ? 128 : 0));
#pragma unroll
    for (int j = 0; j < 4; ++j) { const int n = (lane >> 3) + 8 * j; const LAS float* s = scr + (8 * c) * 33 + n;
        u32x4 o; o.x = pk2(s[0 * 33] * g0.x, s[1 * 33] * g0.y); o.y = pk2(s[2 * 33] * g0.z, s[3 * 33] * g0.w);
        o.z = pk2(s[4 * 33] * g1.x, s[5 * 33] * g1.y); o.w = pk2(s[6 * 33] * g1.z, s[7 * 33] * g1.w);
        *(u32x4*)(WT + (size_t)(drow0 + n) * K + k0 + 8 * c) = o; }
    LDS_WAVE_SYNC();
}

constexpr int I_G = 16 * 88, I_D = 44 * 32, I_IN = 16 * 56, I_OUT = 16 * 32, I_L = 64;
constexpr int PER = 2 * (2 * I_G + I_D) + I_IN + I_OUT + I_L;
__device__ __forceinline__ void convert_items(const Args& a, LAS unsigned char* lds, int l, int it_lo, int it_hi, int gw, int NGW, int wave, int lane) {
    LAS float* scr = (LAS float*)(lds + wave * 8704);
    bf16* WB = (bf16*)(a.ws + WS_W);
#pragma unroll 1
    for (int it = it_lo + gw; it < it_hi; it += NGW) {
        int r = it; bf16* wl = WB + (size_t)l * W_LAYER;
        const size_t o_gu = (size_t)l * D * FF, o_d = (size_t)l * FF * D;
        if (r < I_G) { tr_item<true>(a.in[2] + o_gu, D, FF, wl + W_GU1, 1, a.in[1] + l * D, scr, r, lane); continue; } r -= I_G;
        if (r < I_G) { tr_item<true>(a.in[3] + o_gu, D, FF, wl + W_GU1, 2, a.in[1] + l * D, scr, r, lane); continue; } r -= I_G;
        if (r < I_D) { tr_item<false>(a.in[4] + o_d, FF, D, wl + W_D1, 0, nullptr, scr, r, lane); continue; } r -= I_D;
        if (r < I_IN) { tr_item<true>(a.in[6] + (size_t)l * D * DIN, D, DIN, wl + W_IN, 0, a.in[5] + l * D, scr, r, lane); continue; } r -= I_IN;
        if (r < I_OUT) { tr_item<false>(a.in[18] + (size_t)l * D * D, D, D, wl + W_OUT, 0, nullptr, scr, r, lane); continue; } r -= I_OUT;
        if (r < I_G) { tr_item<true>(a.in[20] + o_gu, D, FF, wl + W_GU2, 1, a.in[19] + l * D, scr, r, lane); continue; } r -= I_G;
        if (r < I_G) { tr_item<true>(a.in[21] + o_gu, D, FF, wl + W_GU2, 2, a.in[19] + l * D, scr, r, lane); continue; } r -= I_G;
        if (r < I_D) { tr_item<false>(a.in[22] + o_d, FF, D, wl + W_D2, 0, nullptr, scr, r, lane); continue; } r -= I_D;
        { const int mat = r >> 1, nbk = r & 1, gate = mat & 1, blk = (mat >> 1) & 7, d = mat >> 4;
          const float* src = (gate ? a.in[11] : a.in[9]) + (size_t)((l * 2 + d) * 8 + blk) * 4096;
          tr_item<false>(src, 64, 64, wl + W_LRU + (size_t)((d * 8 + blk) * 2 + gate) * 4096, 0, nullptr, scr, nbk, lane); }
    }
}
__device__ __forceinline__ void x_prologue(const Args& a, int gw, int NGW, int lane) {
    bf16* XB = (bf16*)(a.ws + WS_XB); float* SS = (float*)(a.ws + WS_SS);
#pragma unroll 1
    for (int m0 = gw; m0 < T; m0 += 4 * NGW) {
        f32x4 v[4][4];
#pragma unroll
        for (int q = 0; q < 4; ++q) { const int m = m0 + q * NGW, mc = m < T ? m : gw; const f32x4* xr = (const f32x4*)(a.in[0] + (size_t)mc * D) + lane;
#pragma unroll
            for (int j = 0; j < 4; ++j) v[q][j] = xr[64 * j]; }
        asm volatile("" ::: "memory");
#pragma unroll
        for (int q = 0; q < 4; ++q) { const int m = m0 + q * NGW; if (m < T) {
            u32x2* xb = (u32x2*)(XB + (size_t)m * D) + lane; float s = 0.f;
#pragma unroll
            for (int j = 0; j < 4; ++j) { const f32x4 w = v[q][j]; s += (w.x * w.x + w.y * w.y) + (w.z * w.z + w.w * w.w);
                u32x2 o; o.x = pk2(w.x, w.y); o.y = pk2(w.z, w.w); xb[64 * j] = o; }
            s = wave_sum(s);
            if (lane < 4) SS[(size_t)m * 4 + lane] = lane == 0 ? s : 0.f; } }
    }
}

template <int DIR, int MODE>
__device__ __forceinline__ void lru_dir(const Args& a, int l, int b, int ch, int w, int lane, const bf16x8 (&af)[4], const float (&xcr)[32], float (&hf)[32],
                                        LAS float* au, const bf16* wl, const float (&gl)[32], const float (&prm)[2][2][3]) {
    const int r32 = lane & 31, h = lane >> 5, c = w * 64 + lane;
    f32x16 accR[2], accI[2];
#pragma unroll
    for (int nt = 0; nt < 2; ++nt) {
#pragma unroll
        for (int i = 0; i < 16; ++i) { accR[nt][i] = 0.f; accI[nt][i] = 0.f; }
        const bf16* wr_ = wl + (size_t)((DIR * 8 + w) * 2) * 4096 + (nt * 32 + r32) * 64 + 8 * h;
#pragma unroll
        for (int ks = 0; ks < 4; ++ks) {
            const bf16x8 bR = *(const bf16x8*)(wr_ + 16 * ks), bI = *(const bf16x8*)(wr_ + 4096 + 16 * ks);
            accR[nt] = MFMA32(af[ks], bR, accR[nt]); accI[nt] = MFMA32(af[ks], bI, accI[nt]); }
    }
#pragma unroll
    for (int nt = 0; nt < 2; ++nt) {
        const float nba = prm[DIR][nt][0], nbx = prm[DIR][nt][1], k8l = prm[DIR][nt][2];
#pragma unroll
        for (int i = 0; i < 16; ++i) {
            const float d1 = 1.f + __builtin_amdgcn_exp2f(__builtin_fmaf(accR[nt][i], -1.4426950408889634f, nba));
            const float d2 = 1.f + __builtin_amdgcn_exp2f(__builtin_fmaf(accI[nt][i], -1.4426950408889634f, nbx));
            const float inv = __builtin_amdgcn_rcpf(d1 * d2), rr = inv * d2, ii = inv * d1;
            const float av = __builtin_amdgcn_exp2f(k8l * rr);
            accR[nt][i] = av; accI[nt][i] = __builtin_amdgcn_sqrtf(fmaxf(__builtin_fmaf(-av, av, 1.f), 0.f)) * ii; }
    }
    float hc = 0.f, ap = 1.f;
    if (MODE == 1) hc = ((const float*)(a.ws + WS_CAR))[(size_t)((b * NCH + ch) * 2 + DIR) * LW + c];
#pragma unroll
    for (int hh = 0; hh < 2; ++hh) {
        const int half = DIR == 0 ? hh : 1 - hh;
#pragma unroll
        for (int nt = 0; nt < 2; ++nt)
#pragma unroll
            for (int i = 0; i < 8; ++i) { const int tt = 8 * (i >> 2) + 4 * h + (i & 3);
                f32x2 v; v.x = accR[nt][8 * half + i]; v.y = accI[nt][8 * half + i];
                *(LAS f32x2*)(au + (tt * 64 + nt * 32 + r32) * 2) = v; }
        LDS_WAVE_SYNC();
#pragma unroll
        for (int s = 0; s < 16; ++s) {
            const int tt = DIR == 0 ? s : 15 - s, t = half * 16 + tt;
            const f32x2 v = *(const LAS f32x2*)(au + (tt * 64 + lane) * 2);
            hc = v.x * hc + v.y * xcr[t];
            if (MODE == 0) { ap *= v.x;
                ((unsigned*)(a.ws + WS_HP))[((size_t)DIR * T + (size_t)b * SEQ + ch * 32 + t) * LW + c] = pg8::cvt_pk_bf16(hc, ap); }
            if (MODE == 1) { if (DIR == 0) hf[t] = hc; else hf[t] = gl[t] * (hf[t] + hc); }
        }
        LDS_WAVE_SYNC();
    }
    if (MODE == 0) { f32x2 v; v.x = ap; v.y = hc; ((f32x2*)(a.ws + WS_TOT))[(size_t)((b * NCH + ch) * 2 + DIR) * LW + c] = v; }
}


__device__ __forceinline__ void carry_phase(const Args& a, int bx) {
    int tid_ = threadIdx.x; asm volatile("" : "+v"(tid_));
    const int gt = bx * NTHR + tid_;
    if (gt >= NB * 2 * LW) return;
    const int b = gt >> 10, dir = (gt >> 9) & 1, c = gt & 511;
    const f32x2* tot = (const f32x2*)(a.ws + WS_TOT); float* car = (float*)(a.ws + WS_CAR);
    float hc = 0.f;
#pragma unroll 1
    for (int j0 = 0; j0 < NCH; j0 += 32) {
        f32x2 v[32];
#pragma unroll
        for (int i = 0; i < 32; ++i) { const int j = j0 + i, cj = dir == 0 ? j : NCH - 1 - j; v[i] = tot[(size_t)((b * NCH + cj) * 2 + dir) * LW + c]; }
#pragma unroll
        for (int i = 0; i < 32; ++i) { const int j = j0 + i, cj = dir == 0 ? j : NCH - 1 - j; car[(size_t)((b * NCH + cj) * 2 + dir) * LW + c] = hc; hc = v[i].x * hc + v[i].y; }
    }
}

template <int MODE>
__device__ __forceinline__ void lru_unit(const Args& a, int l, int b, int ch, LAS unsigned char* lds) {
    int tid_ = threadIdx.x; asm volatile("" : "+v"(tid_));
    const int tid = tid_, w = __builtin_amdgcn_readfirstlane(tid >> 6), lane = tid & 63, r32 = lane & 31, h = lane >> 5;
    const int c = w * 64 + lane, t0 = ch * 32;
    const bf16* proj = (const bf16*)(a.ws + WS_PROJ);
    LAS unsigned char* xcb = lds + w * 12800;
    LAS float* au = (LAS float*)(lds + w * 12800 + 4608);
    const float* cw = a.in[7] + (size_t)l * 4 * LW;
    const float cw0 = cw[c], cw1 = cw[LW + c], cw2 = cw[2 * LW + c], cw3 = cw[3 * LW + c], cb = a.in[8][l * LW + c];
    float prm[2][2][3];
#pragma unroll
    for (int d = 0; d < 2; ++d)
#pragma unroll
        for (int nt = 0; nt < 2; ++nt) { const int cc = (l * 2 + d) * LW + w * 64 + nt * 32 + r32;
            prm[d][nt][0] = a.in[10][cc]; prm[d][nt][1] = a.in[12][cc]; prm[d][nt][2] = a.in[13][cc]; }
    const bf16* xp = proj + (size_t)b * SEQ * DIN + c;
    float xin[35], gl[32];
    unsigned short xraw[35], graw[32];
#pragma unroll
    for (int i = 0; i < 35; ++i) { const int t = t0 - 2 + i, tc = t < 0 ? 0 : (t >= SEQ ? SEQ - 1 : t); xraw[i] = xp[(size_t)tc * DIN]; }
    if (MODE == 1) {
#pragma unroll
        for (int t = 0; t < 32; ++t) graw[t] = xp[(size_t)(t0 + t) * DIN + LW];
    }
    asm volatile("" ::: "memory");
#pragma unroll
    for (int i = 0; i < 35; ++i) { const int t = t0 - 2 + i; xin[i] = (t >= 0 && t < SEQ) ? bf2f(xraw[i]) : 0.f; }
    if (MODE == 1) {
#pragma unroll
        for (int t = 0; t < 32; ++t) gl[t] = gelu_tanh(bf2f(graw[t]));
    }
    float xcr[32], hf[32];
#pragma unroll
    for (int t = 0; t < 32; ++t) { const float xc = cw0 * xin[t] + cw1 * xin[t + 1] + cw2 * xin[t + 2] + cw3 * xin[t + 3] + cb; xcr[t] = xc; hf[t] = 0.f;
        *(LAS bf16*)(xcb + t * 144 + lane * 2) = (bf16)f2bf(xc); }
#pragma unroll
    for (int d = 0; d < 2; ++d)
#pragma unroll
        for (int nt = 0; nt < 2; ++nt) { prm[d][nt][0] *= -1.4426950408889634f; prm[d][nt][1] *= -1.4426950408889634f;
            prm[d][nt][2] = -8.f * 1.4426950408889634f * log1pf(__expf(-prm[d][nt][2])); }
    LDS_WAVE_SYNC();
    bf16x8 af[4];
#pragma unroll
    for (int ks = 0; ks < 4; ++ks) af[ks] = *(const LAS bf16x8*)(xcb + r32 * 144 + (16 * ks + 8 * h) * 2);
    const bf16* wl = (const bf16*)(a.ws + WS_W) + (size_t)l * W_LAYER + W_LRU;
    lru_dir<0, MODE>(a, l, b, ch, w, lane, af, xcr, hf, au, wl, gl, prm);
    lru_dir<1, MODE>(a, l, b, ch, w, lane, af, xcr, hf, au, wl, gl, prm);
    if (MODE == 1) {
        __syncthreads();
        LAS float* yp = (LAS float*)lds;
#pragma unroll
        for (int t = 0; t < 32; ++t) yp[t * LW + c] = hf[t];
        __syncthreads();
        const float* gn = a.in[16] + l * LW + lane * 8;
        const f32x4 g0 = *(const f32x4*)gn, g1 = *(const f32x4*)(gn + 4);
        bf16* Y = (bf16*)(a.ws + WS_Y);
#pragma unroll
        for (int i = 0; i < 4; ++i) { const int t = w * 4 + i;
            const f32x4 v0 = *(const LAS f32x4*)(yp + t * LW + lane * 8), v1 = *(const LAS f32x4*)(yp + t * LW + lane * 8 + 4);
            float s = (v0.x * v0.x + v0.y * v0.y) + (v0.z * v0.z + v0.w * v0.w) + (v1.x * v1.x + v1.y * v1.y) + (v1.z * v1.z + v1.w * v1.w);
            s = wave_sum(s); const float rs = __builtin_amdgcn_rsqf(s * (1.f / 512.f) + 1e-6f);
            u32x4 o; o.x = pk2(v0.x * rs * g0.x, v0.y * rs * g0.y); o.y = pk2(v0.z * rs * g0.z, v0.w * rs * g0.w);
            o.z = pk2(v1.x * rs * g1.x, v1.y * rs * g1.y); o.w = pk2(v1.z * rs * g1.z, v1.w * rs * g1.w);
            *(u32x4*)(Y + ((size_t)b * SEQ + t0 + t) * D + lane * 8) = o; }
    }
}


__device__ __forceinline__ void lru_finish(const Args& a, int l, int gw, int NGW, int lane) {
    const bf16* proj = (const bf16*)(a.ws + WS_PROJ); const unsigned* HP = (const unsigned*)(a.ws + WS_HP); const float* CAR = (const float*)(a.ws + WS_CAR);
    bf16* Y = (bf16*)(a.ws + WS_Y);
    const float* gn = a.in[16] + l * LW + lane * 8;
    const f32x4 gn0 = *(const f32x4*)gn, gn1 = *(const f32x4*)(gn + 4);
#pragma unroll 1
    for (int row = gw; row < T; row += NGW) {
        const int b = row >> 12, ch = (row & (SEQ - 1)) >> 5;
        const unsigned* hpf = HP + (size_t)row * LW + lane * 8; const unsigned* hpb = hpf + (size_t)T * LW;
        const float* cf = CAR + (size_t)((b * NCH + ch) * 2) * LW + lane * 8; const float* cb = cf + LW;
        const u32x4 f0 = *(const u32x4*)hpf, f1 = *(const u32x4*)(hpf + 4), b0 = *(const u32x4*)hpb, b1 = *(const u32x4*)(hpb + 4);
        const u32x4 gq = *(const u32x4*)(proj + (size_t)row * DIN + LW + lane * 8);
        const f32x4 cf0 = *(const f32x4*)cf, cf1 = *(const f32x4*)(cf + 4), cb0 = *(const f32x4*)cb, cb1 = *(const f32x4*)(cb + 4);
        asm volatile("" ::: "memory");
        float y[8]; float s = 0.f;
#pragma unroll
        for (int i = 0; i < 8; ++i) {
            const unsigned fw = i < 4 ? f0[i & 3] : f1[i & 3], bw = i < 4 ? b0[i & 3] : b1[i & 3], gw2 = gq[i >> 1];
            const float cfi = i < 4 ? cf0[i & 3] : cf1[i & 3], cbi = i < 4 ? cb0[i & 3] : cb1[i & 3];
            const float hlf = __builtin_bit_cast(float, fw << 16), pf_ = __builtin_bit_cast(float, fw & 0xffff0000u);
            const float hlb = __builtin_bit_cast(float, bw << 16), pb_ = __builtin_bit_cast(float, bw & 0xffff0000u);
            const float g = __builtin_bit_cast(float, (i & 1) ? (gw2 & 0xffff0000u) : (gw2 << 16));
            y[i] = gelu_tanh(g) * ((hlf + pf_ * cfi) + (hlb + pb_ * cbi)); s += y[i] * y[i]; }
        s = wave_sum(s); const float rs = __builtin_amdgcn_rsqf(s * (1.f / 512.f) + 1e-6f);
        u32x4 o; o.x = pk2(y[0] * rs * gn0.x, y[1] * rs * gn0.y); o.y = pk2(y[2] * rs * gn0.z, y[3] * rs * gn0.w);
        o.z = pk2(y[4] * rs * gn1.x, y[5] * rs * gn1.y); o.w = pk2(y[6] * rs * gn1.z, y[7] * rs * gn1.w);
        *(u32x4*)(Y + (size_t)row * D + lane * 8) = o;
    }
}


__device__ __forceinline__ void lru_finish2(const Args& a, int l, int bx, int G, LAS unsigned char* lds) {
    int tid_ = threadIdx.x; asm volatile("" : "+v"(tid_));
    const int tid = tid_, lane = tid & 63, wave = __builtin_amdgcn_readfirstlane(tid >> 6);
    const bf16* proj = (const bf16*)(a.ws + WS_PROJ); const unsigned* HP = (const unsigned*)(a.ws + WS_HP); const f32x2* tot = (const f32x2*)(a.ws + WS_TOT);
    bf16* Y = (bf16*)(a.ws + WS_Y);
    LAS float* car = (LAS float*)lds;
    const float* gn = a.in[16] + l * LW + lane * 8;
    const f32x4 gn0 = *(const f32x4*)gn, gn1 = *(const f32x4*)(gn + 4);
#pragma unroll 1
    for (int p = bx; p < NB * NCH / 2; p += G) {
        const int b = p / (NCH / 2), ch0 = 2 * (p % (NCH / 2)), ch1 = ch0 + 1;
        __syncthreads();
        { const int c = tid, nf = ch0, nb = NCH - 1 - ch1, nmax = nf > nb ? nf : nb;
          float hf = 0.f, hb = 0.f;
#pragma unroll 1
          for (int j0 = 0; j0 < nmax; j0 += 32) {
              f32x2 vf[32], vb[32];
#pragma unroll
              for (int i = 0; i < 32; ++i) { const int j = j0 + i, jf = j < nf ? j : 0, jb = j < nb ? NCH - 1 - j : NCH - 1;
                  vf[i] = tot[(size_t)((b * NCH + jf) * 2 + 0) * LW + c]; vb[i] = tot[(size_t)((b * NCH + jb) * 2 + 1) * LW + c]; }
              asm volatile("" ::: "memory");
#pragma unroll
              for (int i = 0; i < 32; ++i) { const int j = j0 + i;
                  if (j < nf) hf = vf[i].x * hf + vf[i].y;
                  if (j < nb) hb = vb[i].x * hb + vb[i].y; }
          }
          const f32x2 t0 = tot[(size_t)((b * NCH + ch0) * 2 + 0) * LW + c], t1 = tot[(size_t)((b * NCH + ch1) * 2 + 1) * LW + c];
          car[c] = hf; car[LW + c] = t0.x * hf + t0.y; car[3 * LW + c] = hb; car[2 * LW + c] = t1.x * hb + t1.y; }
        __syncthreads();
#pragma unroll 1
        for (int it = 0; it < 2; ++it) {
            u32x4 f0[4], f1[4], b0[4], b1[4], gq[4];
#pragma unroll
            for (int q = 0; q < 4; ++q) { const int rl = wave * 8 + it * 4 + q; const size_t row = (size_t)b * SEQ + ch0 * 32 + rl;
                const unsigned* hpf = HP + row * LW + lane * 8; const unsigned* hpb = hpf + (size_t)T * LW;
                f0[q] = *(const u32x4*)hpf; f1[q] = *(const u32x4*)(hpf + 4); b0[q] = *(const u32x4*)hpb; b1[q] = *(const u32x4*)(hpb + 4);
                gq[q] = *(const u32x4*)(proj + row * DIN + LW + lane * 8); }
            asm volatile("" ::: "memory");
#pragma unroll
            for (int q = 0; q < 4; ++q) { const int rl = wave * 8 + it * 4 + q, k = rl >> 5; const size_t row = (size_t)b * SEQ + ch0 * 32 + rl;
                const f32x4 cf0 = *(const LAS f32x4*)(car + k * LW + lane * 8), cf1 = *(const LAS f32x4*)(car + k * LW + lane * 8 + 4);
                const f32x4 cb0 = *(const LAS f32x4*)(car + (2 + k) * LW + lane * 8), cb1 = *(const LAS f32x4*)(car + (2 + k) * LW + lane * 8 + 4);
                float y[8]; float s = 0.f;
#pragma unroll
                for (int i = 0; i < 8; ++i) {
                    const unsigned fw = i < 4 ? f0[q][i & 3] : f1[q][i & 3], bw = i < 4 ? b0[q][i & 3] : b1[q][i & 3], gw2 = gq[q][i >> 1];
                    const float cfi = i < 4 ? cf0[i & 3] : cf1[i & 3], cbi = i < 4 ? cb0[i & 3] : cb1[i & 3];
                    const float hlf = __builtin_bit_cast(float, fw << 16), pf_ = __builtin_bit_cast(float, fw & 0xffff0000u);
                    const float hlb = __builtin_bit_cast(float, bw << 16), pb_ = __builtin_bit_cast(float, bw & 0xffff0000u);
                    const float g = __builtin_bit_cast(float, (i & 1) ? (gw2 & 0xffff0000u) : (gw2 << 16));
                    y[i] = gelu_tanh(g) * ((hlf + pf_ * cfi) + (hlb + pb_ * cbi)); s += y[i] * y[i]; }
                s = wave_sum(s); const float rs = __builtin_amdgcn_rsqf(s * (1.f / 512.f) + 1e-6f);
                u32x4 o; o.x = pk2(y[0] * rs * gn0.x, y[1] * rs * gn0.y); o.y = pk2(y[2] * rs * gn0.z, y[3] * rs * gn0.w);
                o.z = pk2(y[4] * rs * gn1.x, y[5] * rs * gn1.y); o.w = pk2(y[6] * rs * gn1.z, y[7] * rs * gn1.w);
                *(u32x4*)(Y + row * D + lane * 8) = o; }
        }
    }
}

__device__ __forceinline__ void lru_finish3(const Args& a, int l, int bx, int G, LAS unsigned char* lds) {
    int tid_ = threadIdx.x; asm volatile("" : "+v"(tid_));
    const int tid = tid_, lane = tid & 63, wave = __builtin_amdgcn_readfirstlane(tid >> 6);
    const bf16* proj = (const bf16*)(a.ws + WS_PROJ); const unsigned* HP = (const unsigned*)(a.ws + WS_HP);
    bf16* Y = (bf16*)(a.ws + WS_Y);
    const float* gn = a.in[16] + l * LW + lane * 8;
    const f32x4 gn0 = *(const f32x4*)gn, gn1 = *(const f32x4*)(gn + 4);
#pragma unroll 1
    for (int p = bx; p < NB * NCH / 2; p += G) {
        const int b = p / (NCH / 2), ch0 = 2 * (p % (NCH / 2)), ch1 = ch0 + 1;
        const int kw = wave >> 2;
        const float* cfp = (const float*)(a.ws + WS_CAR) + (size_t)((b * NCH + ch0 + kw) * 2) * LW + lane * 8;
        const f32x4 cf0 = *(const f32x4*)cfp, cf1 = *(const f32x4*)(cfp + 4), cb0 = *(const f32x4*)(cfp + LW), cb1 = *(const f32x4*)(cfp + LW + 4);
#pragma unroll 1
        for (int it = 0; it < 2; ++it) {
            u32x4 f0[4], f1[4], b0[4], b1[4], gq[4];
#pragma unroll
            for (int q = 0; q < 4; ++q) { const int rl = wave * 8 + it * 4 + q; const size_t row = (size_t)b * SEQ + ch0 * 32 + rl;
                const unsigned* hpf = HP + row * LW + lane * 8; const unsigned* hpb = hpf + (size_t)T * LW;
                f0[q] = *(const u32x4*)hpf; f1[q] = *(const u32x4*)(hpf + 4); b0[q] = *(const u32x4*)hpb; b1[q] = *(const u32x4*)(hpb + 4);
                gq[q] = *(const u32x4*)(proj + row * DIN + LW + lane * 8); }
            asm volatile("" ::: "memory");
#pragma unroll
            for (int q = 0; q < 4; ++q) { const int rl = wave * 8 + it * 4 + q; const size_t row = (size_t)b * SEQ + ch0 * 32 + rl;
                float y[8]; float s = 0.f;
#pragma unroll
                for (int i = 0; i < 8; ++i) {
                    const unsigned fw = i < 4 ? f0[q][i & 3] : f1[q][i & 3], bw = i < 4 ? b0[q][i & 3] : b1[q][i & 3], gw2 = gq[q][i >> 1];
                    const float cfi = i < 4 ? cf0[i & 3] : cf1[i & 3], cbi = i < 4 ? cb0[i & 3] : cb1[i & 3];
                    const float hlf = __builtin_bit_cast(float, fw << 16), pf_ = __builtin_bit_cast(float, fw & 0xffff0000u);
                    const float hlb = __builtin_bit_cast(float, bw << 16), pb_ = __builtin_bit_cast(float, bw & 0xffff0000u);
                    const float g = __builtin_bit_cast(float, (i & 1) ? (gw2 & 0xffff0000u) : (gw2 << 16));
                    y[i] = gelu_tanh(g) * ((hlf + pf_ * cfi) + (hlb + pb_ * cbi)); s += y[i] * y[i]; }
                s = wave_sum(s); const float rs = __builtin_amdgcn_rsqf(s * (1.f / 512.f) + 1e-6f);
                u32x4 o; o.x = pk2(y[0] * rs * gn0.x, y[1] * rs * gn0.y); o.y = pk2(y[2] * rs * gn0.z, y[3] * rs * gn0.w);
                o.z = pk2(y[4] * rs * gn1.x, y[5] * rs * gn1.y); o.w = pk2(y[6] * rs * gn1.z, y[7] * rs * gn1.w);
                *(u32x4*)(Y + row * D + lane * 8) = o; }
        }
    }
}

constexpr int AT_BIAS = 0, AT_RED = 8448, AT_K = 9472, KPITCH = 72, AT_V = AT_K + 320 * KPITCH * 2;
typedef short v4i16_t __attribute__((ext_vector_type(4)));
__device__ __forceinline__ bf16x8 vtr8(const LAS unsigned char* p) {
    const v4i16_t lo = __builtin_amdgcn_ds_read_tr16_b64_v4i16((LAS v4i16_t*)p), hi = __builtin_amdgcn_ds_read_tr16_b64_v4i16((LAS v4i16_t*)(p + 8 * KPITCH * 2));
    return __builtin_shufflevector(lo, hi, 0, 1, 2, 3, 4, 5, 6, 7);
}
__device__ __forceinline__ void attn_unit(const Args& a, int l, int b, int qb, LAS unsigned char* lds) {
    int tid_ = threadIdx.x; asm volatile("" : "+v"(tid_));
    const int tid = tid_, w = __builtin_amdgcn_readfirstlane(tid >> 6), lane = tid & 63, r32 = lane & 31, h = lane >> 5;
    const bf16* proj = (const bf16*)(a.ws + WS_PROJ);
    const LAS float* btab = (const LAS float*)(lds + LDS_BTAB); LAS float* red = (LAS float*)(lds + AT_RED); LAS bf16* Kl = (LAS bf16*)(lds + AT_K); LAS bf16* Vl = (LAS bf16*)(lds + AT_V);
    const size_t rowb = (size_t)b * SEQ; const int q0 = qb * 64, kw0 = q0 - 128;
    const int mt = w & 1, hq = w >> 1, qpos = q0 + mt * 32 + r32;
    const int trofs = (4 * h + ((lane & 15) >> 2)) * (KPITCH * 2) + 32 * ((lane >> 4) & 1) + 8 * (lane & 3);
    f32x16 O[2][2];
#pragma unroll
    for (int kvh = 0; kvh < 2; ++kvh) {
        const int head = kvh * 4 + hq;
        __syncthreads();
        bf16x8 qf[4];
        const float sink_raw = a.in[14][l * 8 + head];
        { u32x4 kq[5], vq[5];
#pragma unroll
          for (int q = 0; q < 5; ++q) { const int it = tid + q * NTHR, key = it >> 3, dc = it & 7, kp = kw0 + key, kc = kp < 0 ? 0 : (kp >= SEQ ? SEQ - 1 : kp);
              const bf16* src = proj + (rowb + kc) * DIN + 1536 + kvh * 64 + dc * 8; kq[q] = *(const u32x4*)src; vq[q] = *(const u32x4*)(src + 128); }
#pragma unroll
          for (int ks = 0; ks < 4; ++ks) qf[ks] = *(const bf16x8*)(proj + (rowb + qpos) * DIN + 1024 + head * 64 + 16 * ks + 8 * h);
          asm volatile("" ::: "memory");
#pragma unroll
          for (int q = 0; q < 5; ++q) { const int it = tid + q * NTHR, key = it >> 3, dc = it & 7, kp = kw0 + key; const bool in = kp >= 0 && kp < SEQ;
              const u32x4 z = (u32x4){0u, 0u, 0u, 0u};
              *(LAS u32x4*)(Kl + key * KPITCH + dc * 8) = in ? kq[q] : z; *(LAS u32x4*)(Vl + key * KPITCH + dc * 8) = in ? vq[q] : z; } }
        __syncthreads();
        const float sink = sink_raw * 1.4426950408889634f;
        float m = sink, lsum = 1.f;
#pragma unroll
        for (int dt = 0; dt < 2; ++dt)
#pragma unroll
            for (int i = 0; i < 16; ++i) O[kvh][dt][i] = 0.f;
        const LAS float* bT = btab + head * 384 + 192 + 4 * h - qpos;
#pragma unroll 1
        for (int jp = 0; jp < 5; ++jp) {
            const int kb0 = kw0 + 64 * jp;
            if (kb0 + 63 < 0 || kb0 >= SEQ) continue;
            f32x16 S0, S1;
#pragma unroll
            for (int i = 0; i < 16; ++i) { S0[i] = 0.f; S1[i] = 0.f; }
            const LAS bf16* kp0 = Kl + (jp * 64 + r32) * KPITCH + 8 * h;
#pragma unroll
            for (int ks = 0; ks < 4; ++ks) { const bf16x8 k0 = *(const LAS bf16x8*)(kp0 + 16 * ks), k1 = *(const LAS bf16x8*)(kp0 + 32 * KPITCH + 16 * ks);
                S0 = MFMA32(k0, qf[ks], S0); S1 = MFMA32(k1, qf[ks], S1); }
            float tmax = -1e30f;
            const LAS float* bp = bT + kb0;
#pragma unroll
            for (int i = 0; i < 16; ++i) {
                const float l0 = __builtin_fmaf(S0[i], 0.125f * 1.4426950408889634f, bp[(i & 3) + 8 * (i >> 2)]), l1 = __builtin_fmaf(S1[i], 0.125f * 1.4426950408889634f, bp[32 + (i & 3) + 8 * (i >> 2)]);
                S0[i] = l0; S1[i] = l1; tmax = fmaxf(tmax, fmaxf(l0, l1)); }
            tmax = fmaxf(tmax, __shfl_xor(tmax, 32));
            const float mnew = fmaxf(m, tmax), alpha = __builtin_amdgcn_exp2f(m - mnew);
            float psum = 0.f;
#pragma unroll
            for (int i = 0; i < 16; ++i) { const float p0 = __builtin_amdgcn_exp2f(S0[i] - mnew), p1 = __builtin_amdgcn_exp2f(S1[i] - mnew);
                S0[i] = p0; S1[i] = p1; psum += p0 + p1; }
            psum += __shfl_xor(psum, 32);
            lsum = lsum * alpha + psum; m = mnew;
            bf16x8 pf[4];
#pragma unroll
            for (int s2 = 0; s2 < 2; ++s2) { u32x4 p; p.x = pg8::cvt_pk_bf16(S0[8 * s2], S0[8 * s2 + 1]); p.y = pg8::cvt_pk_bf16(S0[8 * s2 + 2], S0[8 * s2 + 3]); p.z = pg8::cvt_pk_bf16(S0[8 * s2 + 4], S0[8 * s2 + 5]); p.w = pg8::cvt_pk_bf16(S0[8 * s2 + 6], S0[8 * s2 + 7]);
                pf[s2] = __builtin_bit_cast(bf16x8, p);
                p.x = pg8::cvt_pk_bf16(S1[8 * s2], S1[8 * s2 + 1]); p.y = pg8::cvt_pk_bf16(S1[8 * s2 + 2], S1[8 * s2 + 3]); p.z = pg8::cvt_pk_bf16(S1[8 * s2 + 4], S1[8 * s2 + 5]); p.w = pg8::cvt_pk_bf16(S1[8 * s2 + 6], S1[8 * s2 + 7]);
                pf[2 + s2] = __builtin_bit_cast(bf16x8, p); }
            const bool resc = __builtin_amdgcn_ballot_w64(alpha != 1.f) != 0;
            const LAS unsigned char* vb = (const LAS unsigned char*)Vl + (jp * 64) * (KPITCH * 2) + trofs;
#pragma unroll
            for (int dt = 0; dt < 2; ++dt) {
                if (resc) {
#pragma unroll
                    for (int i = 0; i < 16; ++i) O[kvh][dt][i] *= alpha; }
#pragma unroll
                for (int s4 = 0; s4 < 4; ++s4) { const bf16x8 vf = vtr8(vb + (16 * s4) * (KPITCH * 2) + dt * 64);
                    O[kvh][dt] = MFMA32(vf, pf[s4], O[kvh][dt]); }
            }
        }
        const float inv = __builtin_amdgcn_rcpf(lsum);
#pragma unroll
        for (int dt = 0; dt < 2; ++dt)
#pragma unroll
            for (int i = 0; i < 16; ++i) O[kvh][dt][i] *= inv;
    }
    const float* gn = a.in[17] + l * 512;
    f32x4 gv[2][2][4];
#pragma unroll
    for (int kvh = 0; kvh < 2; ++kvh)
#pragma unroll
        for (int dt = 0; dt < 2; ++dt)
#pragma unroll
            for (int g4 = 0; g4 < 4; ++g4) gv[kvh][dt][g4] = *(const f32x4*)(gn + (kvh * 4 + hq) * 64 + dt * 32 + 8 * g4 + 4 * h);
    asm volatile("" ::: "memory");
    float ssq = 0.f;
#pragma unroll
    for (int kvh = 0; kvh < 2; ++kvh)
#pragma unroll
        for (int dt = 0; dt < 2; ++dt)
#pragma unroll
            for (int i = 0; i < 16; ++i) ssq += O[kvh][dt][i] * O[kvh][dt][i];
    ssq += __shfl_xor(ssq, 32);
    if (h == 0) red[w * 32 + r32] = ssq;
    __syncthreads();
    const float tot = (red[mt * 32 + r32] + red[(mt + 2) * 32 + r32]) + (red[(mt + 4) * 32 + r32] + red[(mt + 6) * 32 + r32]);
    const float rs = __builtin_amdgcn_rsqf(tot * (1.f / 512.f) + 1e-6f);
    bf16* Y = (bf16*)(a.ws + WS_Y) + (rowb + qpos) * D + 512;
#pragma unroll
    for (int kvh = 0; kvh < 2; ++kvh)
#pragma unroll
        for (int dt = 0; dt < 2; ++dt)
#pragma unroll
            for (int g4 = 0; g4 < 4; ++g4) { const int col = (kvh * 4 + hq) * 64 + dt * 32 + 8 * g4 + 4 * h;
                const f32x4 g = gv[kvh][dt][g4];
                u32x2 o; o.x = pk2(O[kvh][dt][4 * g4] * rs * g.x, O[kvh][dt][4 * g4 + 1] * rs * g.y); o.y = pk2(O[kvh][dt][4 * g4 + 2] * rs * g.z, O[kvh][dt][4 * g4 + 3] * rs * g.w);
                *(u32x2*)(Y + col) = o; }
}

#define XB_TMO      128
#define XB_XCNT(j)  (256  + 64 * (j))
#define XB_XSUB(j)  (1280 + 64 * (j))
#define XB_XGEN(j)  (2304 + 64 * (j))
#define XB_TOP      3328
#define XB_TOPGEN   3392
#define XCD_BAR_WORDS 3456
#define XB_SPIN_CAP (1u << 18)

__device__ __forceinline__ unsigned xb_ld(unsigned* p)              { return __hip_atomic_load(p, __ATOMIC_RELAXED, __HIP_MEMORY_SCOPE_AGENT); }
__device__ __forceinline__ unsigned xb_add(unsigned* p, unsigned v) { return __hip_atomic_fetch_add(p, v, __ATOMIC_RELAXED, __HIP_MEMORY_SCOPE_AGENT); }
__device__ __forceinline__ unsigned xb_xcc_id() { return (unsigned)__builtin_amdgcn_s_getreg((3 << 11) | 20) & 0xFu; }
#define XB_SPIN(cond, bar) do { unsigned _sp = 0; while (cond) { __builtin_amdgcn_s_sleep(1); \
    if ((++_sp & 255u) == 0u) { if (xb_ld(&(bar)[XB_TMO])) break; if (_sp > XB_SPIN_CAP) { atomicAdd(&(bar)[XB_TMO], 1u); break; } } } } while (0)

struct XcdBarrier {
    unsigned* bar; unsigned x;
    volatile LAS unsigned* st;
};

__device__ __forceinline__ XcdBarrier xcd_barrier_post(unsigned* bar, volatile LAS unsigned* st) {
    XcdBarrier b; b.bar = bar; b.x = xb_xcc_id(); b.st = st;
    if (threadIdx.x == 0) (void)xb_add(&bar[XB_XCNT(b.x)], 1u);
    return b;
}
__device__ __forceinline__ void xcd_barrier_complete(unsigned* bar, unsigned x, unsigned& nloc, unsigned& nx) {
    const unsigned G = gridDim.x * gridDim.y * gridDim.z;
    unsigned sum, cnt, mine, sp = 0u;
    for (;;) {
        sum = 0u; cnt = 0u; mine = 0u;
#pragma unroll
        for (unsigned j = 0; j < 16; ++j) { const unsigned c = xb_ld(&bar[XB_XCNT(j)]); sum += c; cnt += (c > 0u) ? 1u : 0u; mine = (j == x) ? c : mine; }
        if (sum == G) break;
        __builtin_amdgcn_s_sleep(1);
        if ((++sp & 255u) == 0u) { if (xb_ld(&bar[XB_TMO])) break; if (sp > XB_SPIN_CAP) { atomicAdd(&bar[XB_TMO], 1u); break; } }
    }
    nloc = mine > 0u ? mine : 1u; nx = cnt > 0u ? cnt : 1u;
}

__device__ __forceinline__ void xcd_barrier(const XcdBarrier& b) {
    asm volatile("s_waitcnt vmcnt(0)" ::: "memory");
    __syncthreads();
    if (threadIdx.x == 0) {
        unsigned* bar = b.bar;
        __builtin_amdgcn_s_waitcnt(0);
        unsigned nloc = b.st[0], nx = b.st[1];
        if (nloc == 0u) { xcd_barrier_complete(bar, b.x, nloc, nx); b.st[0] = nloc; b.st[1] = nx; }
        const unsigned old = xb_add(&bar[XB_XSUB(b.x)], 1u);
        const unsigned gen = old / nloc;
        if (old + 1u == (gen + 1u) * nloc) {
            __builtin_amdgcn_fence(__ATOMIC_RELEASE, "agent");
            asm volatile("s_waitcnt vmcnt(0)" ::: "memory");
            const unsigned og = xb_add(&bar[XB_TOP], 1u);
            const unsigned tg = og / nx;
            if (og + 1u == (tg + 1u) * nx) xb_add(&bar[XB_TOPGEN], 1u);
            else XB_SPIN(xb_ld(&bar[XB_TOPGEN]) == tg, bar);
            __builtin_amdgcn_fence(__ATOMIC_ACQUIRE, "agent");
            xb_add(&bar[XB_XGEN(b.x)], 1u);
            asm volatile("s_waitcnt vmcnt(0)" ::: "memory");
        } else {
            XB_SPIN(xb_ld(&bar[XB_XGEN(b.x)]) == gen, bar);
            __builtin_amdgcn_fence(__ATOMIC_ACQUIRE, "agent");
            asm volatile("s_waitcnt vmcnt(0)" ::: "memory");
        }
    }
    __syncthreads();
}

__global__ void __launch_bounds__(NTHR, 2) mega_fwd(Args a) {
    extern __shared__ __attribute__((aligned(16))) unsigned char lds_raw[];
    LAS unsigned char* lds = (LAS unsigned char*)lds_raw;
    cg::grid_group grid = cg::this_grid();
    const int G = gridDim.x, bx = blockIdx.x, NGW = G * NWAVES;
    bf16* XB = (bf16*)(a.ws + WS_XB); bf16* HB = (bf16*)(a.ws + WS_H); bf16* PROJ = (bf16*)(a.ws + WS_PROJ); bf16* Y = (bf16*)(a.ws + WS_Y);
    float* SS = (float*)(a.ws + WS_SS);
    if (blockIdx.x == 0) { for (int i = threadIdx.x; i < XCD_BAR_WORDS; i += NTHR) ((unsigned*)a.ws)[i] = 0u; __threadfence(); }
    grid.sync();
    if (threadIdx.x < 2) ((volatile LAS unsigned*)(lds + 131072))[threadIdx.x] = 0u;
    for (int i = threadIdx.x; i < 8 * 384; i += NTHR) {
        const int hh = i / 384, rel = i % 384 - 192, n = rel < 0 ? -rel : rel; int bk = rel > 0 ? 16 : 0;
        if (n < 8) bk += n; else { int k = 8 + (31 - __builtin_clz(n * n)) - 6; bk += k < 15 ? k : 15; }
        ((LAS float*)(lds + LDS_BTAB))[i] = n <= 128 ? a.in[15][bk * 8 + hh] * 1.4426950408889634f : -1e30f; }
    __syncthreads();
    const XcdBarrier xbar = xcd_barrier_post((unsigned*)a.ws, (volatile LAS unsigned*)(lds + 131072));
#define GSYNC() do { _Pragma("unroll 1") for (int sy_ = 0; sy_ < PROBE_SYNCREP; ++sy_) xcd_barrier(xbar); } while (0)

#pragma unroll 1
    for (int rep = 0; rep < PROBE_PROREP; ++rep)
    { int tid_ = threadIdx.x; asm volatile("" : "+v"(tid_)); const int lane = tid_ & 63, wave = __builtin_amdgcn_readfirstlane(tid_ >> 6);
      _Pragma("unroll 1") for (int cl = 0; cl < (PROBE_NOTAIL ? DEPTH : 1); ++cl) convert_items(a, lds, cl, 0, PER, bx * NWAVES + wave, NGW, wave, lane);
      x_prologue(a, bx * NWAVES + wave, NGW, lane); }
    GSYNC();
    for (int l = 0; l < DEPTH; ++l) {
        const bf16* wl = (const bf16*)(a.ws + WS_W) + (size_t)l * W_LAYER;
#pragma unroll 1
        for (int f = 0; f < 2; ++f) {
            if (f == 1) {
                { pg8::Gemm g{XB, wl + W_IN, T, DIN, D}; pg8::StaticOrder S; S.init(T, DIN, G, bx); pg8::EpiProj E{PROJ, SS};
                  pg8::gemm_phase<pg8::EpiProj, pg8::StaticOrder, true, true>(lds, g, S, E); }
                GSYNC();
#pragma unroll 1
                for (int rep = 0; rep < PROBE_MIXREP; ++rep) {
#pragma unroll 1
                for (int u = bx; u < 256 + NB * NCH; u += G) {
                    __syncthreads();
                    if (u < 256) { _Pragma("unroll 1") for (int rp = 0; rp < PROBE_ATTNREP; ++rp) { attn_unit(a, l, u >> 6, u & 63, lds); __syncthreads(); } }
                    else { const int v = u - 256; _Pragma("unroll 1") for (int rp = 0; rp < PROBE_D1REP; ++rp) lru_unit<0>(a, l, v / NCH, v % NCH, lds); }
                }
                GSYNC();
                carry_phase(a, bx);
                GSYNC();
                _Pragma("unroll 1") for (int rp = 0; rp < PROBE_D2REP; ++rp) lru_finish3(a, l, bx, G, lds);
                GSYNC();
                }
                { pg8::Gemm g{Y, wl + W_OUT, T, D, D}; pg8::StaticOrder S; S.init(T, D, G, bx); pg8::EpiRes E{a.out, a.out, XB, SS, 1.0f, (LAS float*)(lds + 131072 + 256)};
                  pg8::gemm_phase<pg8::EpiRes, pg8::StaticOrder, true, true>(lds, g, S, E); }
                GSYNC();
            }
#pragma unroll 1
            for (int rp = 0; rp < PROBE_GUREP; ++rp)
            { pg8::Gemm g{XB, wl + (f ? W_GU2 : W_GU1), T, NGU, D}; pg8::StaticOrder S; S.init(T, NGU, G, bx); pg8::EpiSwiglu E{HB, SS};
              pg8::gemm_phase<pg8::EpiSwiglu, pg8::StaticOrder, true, true>(lds, g, S, E); }
            { const int first = ((T / 256) * (NGU / 256)) % G, nidle = G - first;
              if (!PROBE_NOTAIL && l + 1 < DEPTH && bx >= first) { int tid_ = threadIdx.x; asm volatile("" : "+v"(tid_)); const int lane = tid_ & 63, wave = __builtin_amdgcn_readfirstlane(tid_ >> 6);
                  convert_items(a, lds, l + 1, f ? PER / 2 : 0, f ? PER : PER / 2, (bx - first) * NWAVES + wave, nidle * NWAVES, wave, lane); } }
            GSYNC();
            { pg8::Gemm g{HB, wl + (f ? W_D2 : W_D1), T, D, FF}; pg8::StaticOrder S; S.init(T, D, G, bx); pg8::EpiRes E{(l == 0 && f == 0) ? a.in[0] : a.out, a.out, XB, SS, 0.5f, (LAS float*)(lds + 131072 + 256)};
              pg8::gemm_phase<pg8::EpiRes, pg8::StaticOrder, true, true>(lds, g, S, E); }
            GSYNC();
        }
    }
    int tid_ = threadIdx.x; asm volatile("" : "+v"(tid_)); const int lane = tid_ & 63, gw = bx * NWAVES + __builtin_amdgcn_readfirstlane(tid_ >> 6);
    const f32x4* gp = (const f32x4*)a.in[23] + lane;
    const f32x4 g0 = gp[0], g1 = gp[64], g2 = gp[128], g3 = gp[192];
#pragma unroll 1
    for (int m0 = gw; m0 < T; m0 += 4 * NGW) {
        f32x4 v[4][4];
#pragma unroll
        for (int q = 0; q < 4; ++q) { const int m = m0 + q * NGW, mc = m < T ? m : gw; const f32x4* xr = (const f32x4*)(a.out + (size_t)mc * D) + lane;
#pragma unroll
            for (int j = 0; j < 4; ++j) v[q][j] = xr[64 * j]; }
        asm volatile("" ::: "memory");
#pragma unroll
        for (int q = 0; q < 4; ++q) { const int m = m0 + q * NGW; if (m < T) {
            f32x4* xr = (f32x4*)(a.out + (size_t)m * D) + lane; float s = 0.f;
#pragma unroll
            for (int j = 0; j < 4; ++j) s += (v[q][j].x * v[q][j].x + v[q][j].y * v[q][j].y) + (v[q][j].z * v[q][j].z + v[q][j].w * v[q][j].w);
            const float rs = __builtin_amdgcn_rsqf(wave_sum(s) * (1.f / D) + 1e-6f);
            xr[0] = v[q][0] * rs * g0; xr[64] = v[q][1] * rs * g1; xr[128] = v[q][2] * rs * g2; xr[192] = v[q][3] * rs * g3; } }
    }
}

extern "C" void kernel_launch(void* const* d_in, const int* in_sizes, int n_in, void* d_out, int out_size, void* d_ws, size_t ws_size, hipStream_t stream) {
    static int grid = 0;
    if (grid == 0) {
        if (n_in != 24 || in_sizes[0] != T * D || out_size != T * D || ws_size < WS_END) { fprintf(stderr, "kernel_launch: unexpected shapes (n_in %d, in0 %d, out %d, ws %zu)\n", n_in, n_in > 0 ? in_sizes[0] : -1, out_size, ws_size); grid = -1; return; }
        int dev = 0, cus = 0, per_cu = 0;
        hipGetDevice(&dev); hipDeviceGetAttribute(&cus, hipDeviceAttributeMultiprocessorCount, dev);
        hipFuncSetAttribute((const void*)mega_fwd, hipFuncAttributeMaxDynamicSharedMemorySize, LDS_BYTES);
        hipOccupancyMaxActiveBlocksPerMultiprocessor(&per_cu, (const void*)mega_fwd, NTHR, LDS_BYTES);
        if (per_cu < 1) per_cu = 1;
        (void)hipGetLastError();
        grid = cus * per_cu;
        fprintf(stderr, "kernel_launch: %d CUs x %d = grid %d\n", cus, per_cu, grid);
    }
    if (grid < 0) return;
    Args a{};
    for (int i = 0; i < 24; ++i) a.in[i] = (const float*)d_in[i];
    a.out = (float*)d_out; a.ws = (unsigned char*)d_ws; a.coop = 1; a.pad = 0;
    void* args[] = {&a};
    hipError_t e = hipLaunchCooperativeKernel((const void*)mega_fwd, dim3(grid), dim3(NTHR), args, LDS_BYTES, stream);
    if (e != hipSuccess) fprintf(stderr, "cooperative launch failed: %s (grid %d)\n", hipGetErrorString(e), grid);
}
```

```cpp
#include <hip/hip_runtime.h>
#include <hip/hip_cooperative_groups.h>
#include <cstdio>
#include <cstdint>
namespace cg = cooperative_groups;
#define PROBE_MIXREP 1
#define PROBE_SYNCREP 1
#define PROBE_PROREP 1
#define PROBE_ATTNREP 1
#define PROBE_D1REP 1
#define PROBE_D2REP 1
#define PROBE_GUREP 1
#define PROBE_NOTAIL 0
namespace pg8 {
#define PG8_LAS __attribute__((address_space(3)))
typedef unsigned short bf16_t;
typedef short bf16x8 __attribute__((ext_vector_type(8)));
typedef float f32x4 __attribute__((ext_vector_type(4)));
typedef unsigned u32x4 __attribute__((ext_vector_type(4)));
constexpr int BM = 256, BK = 64, HALF = 128, HTB = HALF * BK * 2  , STAGE_BYTES = 8 * HTB, NXCD = 8, WGM = 8;

__host__ __device__ __forceinline__ int lds_byte(int r, int c) { const int st = (r >> 4) * 2 + (c >> 5), rr = r & 15, cc = c & 31, ob = rr * 64 + cc * 2; return st * 1024 + (ob ^ (((ob >> 9) & 1) << 5)); }
__host__ __device__ __forceinline__ void stage_rc(int b, int& R, int& C) { const int st = b / 1024, sb = b % 1024, swz = sb ^ (((sb >> 9) & 1) << 5); R = (st >> 1) * 16 + swz / 64; C = (st & 1) * 32 + (swz % 64) / 2; }
__host__ __device__ __forceinline__ int perm32(int rho) { const int n = rho >> 4, i = rho & 15; return 8 * (i >> 2) + 4 * n + (i & 3); }

struct Unit { int pm, pn; };
struct Gemm { const bf16_t* A; const bf16_t* Bt; int M, N, K; };

struct StaticOrder {
    int nM, nN, nwg, G, c;
    __host__ __device__ void init(int M, int N, int G_, int c_) { nM = M / BM; nN = N / BM; nwg = nM * nN; G = G_; c = c_; }
    __host__ __device__ bool next(int i, Unit& u) const {
        const long L = (long)i * G + c; if (L >= nwg) return false;
        int wgid = (int)L; { const int q = nwg / NXCD, r = nwg % NXCD, xcd = wgid % NXCD, off = wgid / NXCD; wgid = (xcd < r ? xcd * (q + 1) : r * (q + 1) + (xcd - r) * q) + off; }
        const int nig = WGM * nN, gid = wgid / nig, fm = gid * WGM, gsz = (nM - fm) < WGM ? (nM - fm) : WGM;
        u.pm = fm + ((wgid % nig) % gsz); u.pn = (wgid % nig) / gsz; return true;
    }
    __device__ __forceinline__ void a_ready(const Unit&) const {}
    __device__ __forceinline__ void done(const Unit&) const {}
};

__device__ __forceinline__ unsigned cvt_pk_bf16(float lo, float hi) { unsigned r; asm volatile("v_cvt_pk_bf16_f32 %0, %1, %2" : "=v"(r) : "v"(lo), "v"(hi)); return r; }
template <class Epi, class Sched, bool ALIGN_EPI = false, bool SP2 = false>
__device__ __forceinline__ void gemm_phase(PG8_LAS unsigned char* lds, const Gemm g, const Sched& S, const Epi& E) {
    int tid_ = threadIdx.x; asm volatile("" : "+v"(tid_));
    const int tid = tid_, wid = __builtin_amdgcn_readfirstlane(tid >> 6), lane = tid & 63, wr = wid >> 2, wc = wid & 3, fr = lane & 15, fq = lane >> 4;
    const int K = g.K, nt = K / BK;
    unsigned voffA[2], voffB[2];
#pragma unroll
    for (int i = 0; i < 2; ++i) { int R, C; stage_rc(tid * 16 + i * 8192, R, C); const int Rb = Epi::PERM ? ((R & ~31) + perm32(R & 31)) : R;
        voffA[i] = (unsigned)(R * K + C) * 2u; voffB[i] = (unsigned)(Rb * K + C) * 2u; }
    const size_t kstep = (size_t)(BK * 2);
    const size_t hstep = (size_t)HALF * K * 2;
    const size_t tstep = 2 * hstep;
    const unsigned ldsw = (unsigned)wid * 1024u;
    const int aoff = lds_byte(wr * 64 + fr, fq * 8), boff = lds_byte(wc * 32 + fr, fq * 8);
#define PG8_SA(b, h) (((b) * 2 + (h)) * HTB)
#define PG8_SB(b, h) ((4 + (b) * 2 + (h)) * HTB)
#define PG8_STAGE(bufoff, gbase, voff) do { _Pragma("unroll") for (int _i = 0; _i < 2; ++_i) \
        __builtin_amdgcn_global_load_lds((const unsigned*)((const char*)(gbase) + (voff)[_i]), (PG8_LAS unsigned*)(lds + (bufoff) + ldsw + _i * 8192), 16, 0, 0); } while (0)
#define PG8_LDA(dst, b, h) do { _Pragma("unroll") for (int m = 0; m < 4; ++m) _Pragma("unroll") for (int k = 0; k < 2; ++k) dst[m][k] = *(const PG8_LAS bf16x8*)(lds + PG8_SA(b, h) + aoff + m * 2048 + k * 1024); } while (0)
#define PG8_LDB(dst, b, h) do { _Pragma("unroll") for (int n = 0; n < 2; ++n) _Pragma("unroll") for (int k = 0; k < 2; ++k) dst[n][k] = *(const PG8_LAS bf16x8*)(lds + PG8_SB(b, h) + boff + n * 2048 + k * 1024); } while (0)
#define PG8_MMA(ai, bj, At, Bt) do { __builtin_amdgcn_s_setprio(1); _Pragma("unroll") for (int m = 0; m < 4; ++m) _Pragma("unroll") for (int n = 0; n < 2; ++n) _Pragma("unroll") for (int k = 0; k < 2; ++k) \
        acc[ai][bj][m][n] = __builtin_amdgcn_mfma_f32_16x16x32_bf16(Bt[n][k], At[m][k], acc[ai][bj][m][n], 0, 0, 0); __builtin_amdgcn_s_setprio(0); } while (0)
#define PG8_WAIT_V(n) asm volatile("s_waitcnt vmcnt(" #n ")" ::: "memory")
#define PG8_WAIT_L(n) asm volatile("s_waitcnt lgkmcnt(" #n ")" ::: "memory")
#define PG8_BAR __builtin_amdgcn_s_barrier()
#define PG8_SCHED __builtin_amdgcn_sched_barrier(0)
    Unit cur, nxt; int ui = 0;
    if (!S.next(0, cur)) return;
    f32x4 acc[2][2][4][2];
#pragma unroll
    for (int a = 0; a < 2; ++a)
#pragma unroll
        for (int b = 0; b < 2; ++b)
#pragma unroll
            for (int m = 0; m < 4; ++m)
#pragma unroll
                for (int n = 0; n < 2; ++n) acc[a][b][m][n] = (f32x4){0.f, 0.f, 0.f, 0.f};
    bf16x8 At[4][2], B0[2][2], B1[2][2];
    const char* cA = (const char*)g.A + (size_t)cur.pm * tstep; const char* cB = (const char*)g.Bt + (size_t)cur.pn * tstep;
    S.a_ready(cur);
    if constexpr (SP2) {
        PG8_STAGE(PG8_SB(0, 0), cB, voffB); PG8_STAGE(PG8_SB(0, 1), cB + hstep, voffB); PG8_STAGE(PG8_SA(0, 0), cA, voffA); PG8_STAGE(PG8_SA(0, 1), cA + hstep, voffA);
        if (wr == 1) PG8_BAR;
        PG8_WAIT_V(2); PG8_BAR;
        PG8_STAGE(PG8_SB(1, 0), cB + kstep, voffB); PG8_STAGE(PG8_SA(1, 0), cA + kstep, voffA); PG8_STAGE(PG8_SB(1, 1), cB + hstep + kstep, voffB);
        PG8_WAIT_V(6); PG8_BAR;
    } else {
        PG8_STAGE(PG8_SB(0, 0), cB, voffB); PG8_STAGE(PG8_SA(0, 0), cA, voffA); PG8_STAGE(PG8_SB(0, 1), cB + hstep, voffB); PG8_STAGE(PG8_SA(0, 1), cA + hstep, voffA);
        if (wr == 1) PG8_BAR;
        PG8_WAIT_V(4); PG8_BAR;
        PG8_STAGE(PG8_SB(1, 0), cB + kstep, voffB); PG8_STAGE(PG8_SA(1, 0), cA + kstep, voffA); PG8_STAGE(PG8_SB(1, 1), cB + hstep + kstep, voffB);
        PG8_WAIT_V(6); PG8_BAR;
    }
    for (;;) {
        const bool has_next = S.next(ui + 1, nxt);
        const char* nA = has_next ? (const char*)g.A + (size_t)nxt.pm * tstep : cA; const char* nB = has_next ? (const char*)g.Bt + (size_t)nxt.pn * tstep : cB;
        for (int t = 0; t < nt; t += 2) {
            const bool last = (t == nt - 2);
            const char* a1 = cA + (size_t)(t + 1) * kstep;
            const char* a2 = last ? nA : cA + (size_t)(t + 2) * kstep; const char* b2 = last ? nB : cB + (size_t)(t + 2) * kstep;
            const char* a3 = a2 + kstep; const char* b3 = b2 + kstep;
            if (last && has_next) S.a_ready(nxt);
            if constexpr (SP2) {
            PG8_LDB(B0, 0, 0); PG8_LDB(B1, 0, 1); PG8_SCHED; PG8_LDA(At, 0, 0); PG8_STAGE(PG8_SA(1, 1), a1 + hstep, voffA);
            PG8_WAIT_V(8); PG8_WAIT_L(0); PG8_BAR; PG8_MMA(0, 0, At, B0); PG8_MMA(0, 1, At, B1); PG8_BAR; PG8_SCHED;
            PG8_LDA(At, 0, 1); PG8_STAGE(PG8_SB(0, 0), b2, voffB); PG8_STAGE(PG8_SB(0, 1), b2 + hstep, voffB); PG8_STAGE(PG8_SA(0, 0), a2, voffA);
            PG8_WAIT_V(8); PG8_WAIT_L(0); PG8_BAR; PG8_MMA(1, 0, At, B0); PG8_MMA(1, 1, At, B1); PG8_BAR; PG8_SCHED;
            PG8_LDB(B0, 1, 0); PG8_LDB(B1, 1, 1); PG8_SCHED; PG8_LDA(At, 1, 0); PG8_STAGE(PG8_SA(0, 1), a2 + hstep, voffA);
            PG8_WAIT_V(8); PG8_WAIT_L(0); PG8_BAR; PG8_MMA(0, 0, At, B0); PG8_MMA(0, 1, At, B1); PG8_BAR; PG8_SCHED;
            PG8_LDA(At, 1, 1); PG8_STAGE(PG8_SB(1, 0), b3, voffB); PG8_STAGE(PG8_SB(1, 1), b3 + hstep, voffB); PG8_STAGE(PG8_SA(1, 0), a3, voffA);
            PG8_WAIT_V(8); PG8_WAIT_L(0); PG8_BAR; PG8_MMA(1, 0, At, B0); PG8_MMA(1, 1, At, B1); PG8_BAR; PG8_SCHED;
            } else {
            PG8_LDB(B0, 0, 0); PG8_SCHED; PG8_LDA(At, 0, 0); PG8_STAGE(PG8_SA(1, 1), a1 + hstep, voffA);
            PG8_WAIT_L(8); PG8_BAR; PG8_WAIT_L(0); PG8_MMA(0, 0, At, B0); PG8_BAR; PG8_SCHED;
            PG8_LDB(B1, 0, 1); PG8_STAGE(PG8_SB(0, 0), b2, voffB);
            PG8_BAR; PG8_WAIT_L(0); PG8_MMA(0, 1, At, B1); PG8_BAR;
            PG8_LDA(At, 0, 1); PG8_STAGE(PG8_SA(0, 0), a2, voffA);
            PG8_BAR; PG8_WAIT_L(0); PG8_MMA(1, 0, At, B0); PG8_BAR; PG8_SCHED;
            PG8_STAGE(PG8_SB(0, 1), b2 + hstep, voffB);
            PG8_WAIT_V(6); PG8_BAR; PG8_MMA(1, 1, At, B1); PG8_BAR;
            PG8_LDB(B0, 1, 0); PG8_SCHED; PG8_LDA(At, 1, 0); PG8_STAGE(PG8_SA(0, 1), a2 + hstep, voffA);
            PG8_WAIT_L(8); PG8_BAR; PG8_WAIT_L(0); PG8_MMA(0, 0, At, B0); PG8_BAR; PG8_SCHED;
            PG8_LDB(B1, 1, 1); PG8_STAGE(PG8_SB(1, 0), b3, voffB);
            PG8_BAR; PG8_WAIT_L(0); PG8_MMA(0, 1, At, B1); PG8_BAR;
            PG8_LDA(At, 1, 1); PG8_STAGE(PG8_SA(1, 0), a3, voffA);
            PG8_BAR; PG8_WAIT_L(0); PG8_MMA(1, 0, At, B0); PG8_BAR; PG8_SCHED;
            PG8_STAGE(PG8_SB(1, 1), b3 + hstep, voffB);
            PG8_WAIT_V(6); PG8_BAR; PG8_MMA(1, 1, At, B1); PG8_BAR;
            }
        }
        if constexpr (ALIGN_EPI) { if (wr == 0) PG8_BAR; }
        if constexpr (!Epi::AFTER_DRAIN) { E(acc, cur, wr, wc, fr, fq); S.done(cur); }
        if (!has_next) break;
#pragma unroll
        for (int a = 0; a < 2; ++a)
#pragma unroll
            for (int b = 0; b < 2; ++b)
#pragma unroll
                for (int m = 0; m < 4; ++m)
#pragma unroll
                    for (int n = 0; n < 2; ++n) acc[a][b][m][n] = (f32x4){0.f, 0.f, 0.f, 0.f};
        cur = nxt; cA = nA; cB = nB; ++ui;
        if constexpr (ALIGN_EPI) { if (wr == 1) PG8_BAR; }
    }
    PG8_WAIT_V(0);
    if constexpr (!ALIGN_EPI) { if (wr == 0) PG8_BAR; }
    PG8_BAR;
    if constexpr (Epi::AFTER_DRAIN) { E.fused(acc, cur, wr, wc, fr, fq, lds, wid, lane); S.done(cur); }
#undef PG8_SA
#undef PG8_SB
#undef PG8_STAGE
#undef PG8_LDA
#undef PG8_LDB
#undef PG8_MMA
#undef PG8_WAIT_V
#undef PG8_WAIT_L
#undef PG8_BAR
#undef PG8_SCHED
}
}

namespace pg8 {
typedef float f32x2 __attribute__((ext_vector_type(2)));
__device__ __forceinline__ void rows_rstd(const float* ss, int row0, float (&rs)[2][4]) {
    f32x4 p[2][4];
#pragma unroll
    for (int ai = 0; ai < 2; ++ai)
#pragma unroll
        for (int m = 0; m < 4; ++m) p[ai][m] = *(const f32x4*)(ss + (size_t)(row0 + ai * HALF + m * 16) * 4);
    asm volatile("" ::: "memory");
#pragma unroll
    for (int ai = 0; ai < 2; ++ai)
#pragma unroll
        for (int m = 0; m < 4; ++m) rs[ai][m] = __builtin_amdgcn_rsqf(((p[ai][m].x + p[ai][m].y) + (p[ai][m].z + p[ai][m].w)) * (1.f / 1024.f) + 1e-6f);
}

struct EpiSwiglu {
    static constexpr bool PERM = true, AFTER_DRAIN = false;
    bf16_t* H; const float* ss;
    __device__ __forceinline__ void operator()(const f32x4 (&acc)[2][2][4][2], const Unit& u, int wr, int wc, int fr, int fq) const {
        const int row0 = u.pm * BM + wr * 64 + fr, col0 = u.pn * 128 + wc * 32 + 8 * fq;
        float rsv[2][4]; rows_rstd(ss, row0, rsv);
#pragma unroll
        for (int ai = 0; ai < 2; ++ai)
#pragma unroll
            for (int m = 0; m < 4; ++m) {
                const int row = row0 + ai * HALF + m * 16; const float rs = rsv[ai][m], c1 = rs * -1.4426950408889634f, rs2 = rs * rs;
                u32x4 w;
#pragma unroll
                for (int q = 0; q < 4; ++q) {
                    const f32x4 G4 = acc[ai][0][m][q >> 1], U4 = acc[ai][1][m][q >> 1];
                    const f32x2 G = (q & 1) ? (f32x2){G4.z, G4.w} : (f32x2){G4.x, G4.y}, U = (q & 1) ? (f32x2){U4.z, U4.w} : (f32x2){U4.x, U4.y}, t = G * c1;
                    f32x2 e; e.x = __builtin_amdgcn_exp2f(t.x); e.y = __builtin_amdgcn_exp2f(t.y);
                    const f32x2 d = e + 1.f;
                    f32x2 r; r.x = __builtin_amdgcn_rcpf(d.x); r.y = __builtin_amdgcn_rcpf(d.y);
                    const f32x2 o = (G * U) * (r * rs2);
                    const unsigned pk = cvt_pk_bf16(o.x, o.y);
                    if (q == 0) w.x = pk; else if (q == 1) w.y = pk; else if (q == 2) w.z = pk; else w.w = pk; }
                *(u32x4*)(H + (size_t)row * 2816 + col0) = w; }
    }
};
struct EpiRes {
    static constexpr bool PERM = true, AFTER_DRAIN = false;
    bf16_t* XB; float* ss; float scale; PG8_LAS float* red;
    __device__ __forceinline__ void operator()(const f32x4 (&acc)[2][2][4][2], const Unit& u, int wr, int wc, int fr, int fq) const {
        const int row0 = u.pm * BM + wr * 64 + fr, col0 = u.pn * BM + wc * 32 + 8 * fq;
        u32x4 xv[2][4][2];
#pragma unroll
        for (int ai = 0; ai < 2; ++ai)
#pragma unroll
            for (int m = 0; m < 4; ++m)
#pragma unroll
                for (int bj = 0; bj < 2; ++bj) xv[ai][m][bj] = *(const u32x4*)(XB + (size_t)(row0 + ai * HALF + m * 16) * 1024 + col0 + bj * HALF);
        asm volatile("" ::: "memory");
#pragma unroll
        for (int ai = 0; ai < 2; ++ai)
#pragma unroll
            for (int m = 0; m < 4; ++m) {
                const int row = row0 + ai * HALF + m * 16; float sq = 0.f;
#pragma unroll
                for (int bj = 0; bj < 2; ++bj) {
                    const u32x4 o = xv[ai][m][bj];
                    const f32x4 p0 = (f32x4){__builtin_bit_cast(float, o.x << 16), __builtin_bit_cast(float, o.x & 0xffff0000u), __builtin_bit_cast(float, o.y << 16), __builtin_bit_cast(float, o.y & 0xffff0000u)};
                    const f32x4 p1 = (f32x4){__builtin_bit_cast(float, o.z << 16), __builtin_bit_cast(float, o.z & 0xffff0000u), __builtin_bit_cast(float, o.w << 16), __builtin_bit_cast(float, o.w & 0xffff0000u)};
                    const f32x4 x0 = p0 + acc[ai][bj][m][0] * scale, x1 = p1 + acc[ai][bj][m][1] * scale;
                    u32x4 w; w.x = cvt_pk_bf16(x0[0], x0[1]); w.y = cvt_pk_bf16(x0[2], x0[3]); w.z = cvt_pk_bf16(x1[0], x1[1]); w.w = cvt_pk_bf16(x1[2], x1[3]);
                    *(u32x4*)(XB + (size_t)row * 1024 + col0 + bj * HALF) = w;
                    sq += (x0[0] * x0[0] + x0[1] * x0[1]) + (x0[2] * x0[2] + x0[3] * x0[3]) + (x1[0] * x1[0] + x1[1] * x1[1]) + (x1[2] * x1[2] + x1[3] * x1[3]); }
                sq += __shfl_xor(sq, 16); sq += __shfl_xor(sq, 32);
                if (fq == 0) red[(wr * 64 + fr + ai * HALF + m * 16) * 4 + wc] = sq; }
        asm volatile("s_waitcnt lgkmcnt(0)" ::: "memory"); __builtin_amdgcn_s_barrier();
        { const int t = threadIdx.x; if (t < 256) { const f32x4 p = *(const PG8_LAS f32x4*)(red + t * 4); ss[(size_t)(u.pm * BM + t) * 4 + u.pn] = (p.x + p.y) + (p.z + p.w); } }
        asm volatile("s_waitcnt lgkmcnt(0)" ::: "memory"); __builtin_amdgcn_s_barrier();
    }
};
struct EpiProj {
    static constexpr bool PERM = true, AFTER_DRAIN = false;
    bf16_t* P; const float* ss;
    __device__ __forceinline__ void operator()(const f32x4 (&acc)[2][2][4][2], const Unit& u, int wr, int wc, int fr, int fq) const {
        const int row0 = u.pm * BM + wr * 64 + fr, col0 = u.pn * BM + wc * 32 + 8 * fq;
        float rsv[2][4]; rows_rstd(ss, row0, rsv);
#pragma unroll
        for (int ai = 0; ai < 2; ++ai)
#pragma unroll
            for (int m = 0; m < 4; ++m) {
                const int row = row0 + ai * HALF + m * 16; const float rs = rsv[ai][m];
#pragma unroll
                for (int bj = 0; bj < 2; ++bj) {
                    const f32x4 v0 = acc[ai][bj][m][0] * rs, v1 = acc[ai][bj][m][1] * rs;
                    u32x4 w; w.x = cvt_pk_bf16(v0[0], v0[1]); w.y = cvt_pk_bf16(v0[2], v0[3]); w.z = cvt_pk_bf16(v1[0], v1[1]); w.w = cvt_pk_bf16(v1[2], v1[3]);
                    *(u32x4*)(P + (size_t)row * 1792 + col0 + bj * HALF) = w; } }
    }
};
}

#define LAS __attribute__((address_space(3)))
typedef unsigned short bf16;
typedef short bf16x8 __attribute__((ext_vector_type(8)));
typedef float f32x4 __attribute__((ext_vector_type(4)));
typedef float f32x2 __attribute__((ext_vector_type(2)));
typedef float f32x16 __attribute__((ext_vector_type(16)));
typedef unsigned u32x4 __attribute__((ext_vector_type(4)));
typedef unsigned u32x2 __attribute__((ext_vector_type(2)));
#define MFMA32(a, b, c) __builtin_amdgcn_mfma_f32_32x32x16_bf16((a), (b), (c), 0, 0, 0)

constexpr int NB = 4, SEQ = 4096, T = NB * SEQ, D = 1024, FF = 2816, NGU = 2 * FF, DIN = 1792, DEPTH = 4, LW = 512;
constexpr int NCH = SEQ / 32;
constexpr int NWAVES = 8, NTHR = 512;
constexpr int LDS_BTAB = 131072 + 256 + 4096, LDS_RSTD = LDS_BTAB + 8 * 384 * 4, LDS_BYTES = LDS_RSTD + 2048;
constexpr size_t W_GU1 = 0, W_D1 = W_GU1 + (size_t)NGU * D, W_IN = W_D1 + (size_t)D * FF, W_OUT = W_IN + (size_t)DIN * D, W_GU2 = W_OUT + (size_t)D * D,
                 W_D2 = W_GU2 + (size_t)NGU * D, W_LRU = W_D2 + (size_t)D * FF, W_LAYER = W_LRU + 131072;
constexpr size_t MiB = 1u << 20;
constexpr size_t WS_W = 1 * MiB, WS_XB = 160 * MiB, WS_H = 192 * MiB, WS_PROJ = WS_H, WS_Y = WS_H + 56 * MiB, WS_SS = 280 * MiB, WS_TOT = 281 * MiB, WS_CAR = 285 * MiB, WS_HP = 287 * MiB, WS_END = 351 * MiB;
static_assert(WS_W + W_LAYER * 2 * DEPTH <= WS_XB && (size_t)T * FF * 2 <= 88 * MiB && (size_t)T * DIN * 2 <= 56 * MiB, "ws map");

struct Args { const float* in[24]; float* out; unsigned char* ws; int coop; int pad; };


__device__ __forceinline__ unsigned f2bf(float f) { unsigned u = __builtin_bit_cast(unsigned, f); return (u + 0x7fffu + ((u >> 16) & 1u)) >> 16; }
__device__ __forceinline__ unsigned pk2(float lo, float hi) { return f2bf(lo) | (f2bf(hi) << 16); }
__device__ __forceinline__ float bf2f(unsigned short b) { return __builtin_bit_cast(float, (unsigned)b << 16); }
__device__ __forceinline__ float wave_sum(float v) {
#pragma unroll
    for (int o = 1; o < 64; o <<= 1) v += __shfl_xor(v, o);
    return v;
}
#define LDS_WAVE_SYNC() asm volatile("s_waitcnt lgkmcnt(0)" ::: "memory")
__device__ __forceinline__ float sigmoid_f(float x) { return __builtin_amdgcn_rcpf(1.f + __expf(-x)); }
__device__ __forceinline__ float gelu_tanh(float x) {
    const float z = 0.7978845608028654f * (x + 0.044715f * x * x * x);
    const float e = __expf(2.f * z);
    const float th = 1.f - 2.f * __builtin_amdgcn_rcpf(e + 1.f);
    return 0.5f * x * (1.f + th);
}

template <bool HASG>
__device__ __forceinline__ void tr_item(const float* W, int K, int N, bf16* WT, int rowmode, const float* g, LAS float* scr, int item, int lane) {
    const int nblk = N / 32, kb = item / nblk, nb = item % nblk, k0 = 64 * kb, n0 = 32 * nb;
    const float* wp = W + (size_t)(k0 + (lane >> 5)) * N + n0 + (lane & 31);
    const int c = lane & 7;
    float v[32];
#pragma unroll
    for (int i = 0; i < 32; ++i) v[i] = wp[(size_t)(2 * i) * N];
    f32x4 g0 = (f32x4){1.f, 1.f, 1.f, 1.f}, g1 = g0;
    if (HASG) { g0 = *(const f32x4*)(g + k0 + 8 * c); g1 = *(const f32x4*)(g + k0 + 8 * c + 4); }
    asm volatile("" ::: "memory");
#pragma unroll
    for (int i = 0; i < 32; ++i) scr[(2 * i + (lane >> 5)) * 33 + (lane & 31)] = v[i];
    LDS_WAVE_SYNC();
    const int drow0 = rowmode == 0 ? n0 : ((n0 >> 7) * 256 + (n0 & 127) + (rowmode == 2 ? 128 : 0));
#pragma unroll
    for (int j = 0; j < 4; ++j) { const int n = (lane >> 3) + 8 * j; const LAS float* s = scr + (8 * c) * 33 + n;
        u32x4 o; o.x = pk2(s[0 * 33] * g0.x, s[1 * 33] * g0.y); o.y = pk2(s[2 * 33] * g0.z, s[3 * 33] * g0.w);
        o.z = pk2(s[4 * 33] * g1.x, s[5 * 33] * g1.y); o.w = pk2(s[6 * 33] * g1.z, s[7 * 33] * g1.w);
        *(u32x4*)(WT + (size_t)(drow0 + n) * K + k0 + 8 * c) = o; }
    LDS_WAVE_SYNC();
}

constexpr int I_G = 16 * 88, I_D = 44 * 32, I_IN = 16 * 56, I_OUT = 16 * 32, I_L = 64;
constexpr int PER = 2 * (2 * I_G + I_D) + I_IN + I_OUT + I_L;
__device__ __forceinline__ void convert_items(const Args& a, LAS unsigned char* lds, int l, int it_lo, int it_hi, int gw, int NGW, int wave, int lane) {
    LAS float* scr = (LAS float*)(lds + wave * 8704);
    bf16* WB = (bf16*)(a.ws + WS_W);
#pragma unroll 1
    for (int it = it_lo + gw; it < it_hi; it += NGW) {
        int r = it; bf16* wl = WB + (size_t)l * W_LAYER;
        const size_t o_gu = (size_t)l * D * FF, o_d = (size_t)l * FF * D;
        if (r < I_G) { tr_item<true>(a.in[2] + o_gu, D, FF, wl + W_GU1, 1, a.in[1] + l * D, scr, r, lane); continue; } r -= I_G;
        if (r < I_G) { tr_item<true>(a.in[3] + o_gu, D, FF, wl + W_GU1, 2, a.in[1] + l * D, scr, r, lane); continue; } r -= I_G;
        if (r < I_D) { tr_item<false>(a.in[4] + o_d, FF, D, wl + W_D1, 0, nullptr, scr, r, lane); continue; } r -= I_D;
        if (r < I_IN) { tr_item<true>(a.in[6] + (size_t)l * D * DIN, D, DIN, wl + W_IN, 0, a.in[5] + l * D, scr, r, lane); continue; } r -= I_IN;
        if (r < I_OUT) { tr_item<false>(a.in[18] + (size_t)l * D * D, D, D, wl + W_OUT, 0, nullptr, scr, r, lane); continue; } r -= I_OUT;
        if (r < I_G) { tr_item<true>(a.in[20] + o_gu, D, FF, wl + W_GU2, 1, a.in[19] + l * D, scr, r, lane); continue; } r -= I_G;
        if (r < I_G) { tr_item<true>(a.in[21] + o_gu, D, FF, wl + W_GU2, 2, a.in[19] + l * D, scr, r, lane); continue; } r -= I_G;
        if (r < I_D) { tr_item<false>(a.in[22] + o_d, FF, D, wl + W_D2, 0, nullptr, scr, r, lane); continue; } r -= I_D;
        { const int mat = r >> 1, nbk = r & 1, gate = mat & 1, blk = (mat >> 1) & 7, d = mat >> 4;
          const float* src = (gate ? a.in[11] : a.in[9]) + (size_t)((l * 2 + d) * 8 + blk) * 4096;
          tr_item<false>(src, 64, 64, wl + W_LRU + (size_t)((d * 8 + blk) * 2 + gate) * 4096, 0, nullptr, scr, nbk, lane); }
    }
}
__device__ __forceinline__ void x_prologue(const Args& a, int gw, int NGW, int lane) {
    bf16* XB = (bf16*)(a.ws + WS_XB); float* SS = (float*)(a.ws + WS_SS);
#pragma unroll 1
    for (int m0 = gw; m0 < T; m0 += 4 * NGW) {
        f32x4 v[4][4];
#pragma unroll
        for (int q = 0; q < 4; ++q) { const int m = m0 + q * NGW, mc = m < T ? m : gw; const f32x4* xr = (const f32x4*)(a.in[0] + (size_t)mc * D) + lane;
#pragma unroll
            for (int j = 0; j < 4; ++j) v[q][j] = xr[64 * j]; }
        asm volatile("" ::: "memory");
#pragma unroll
        for (int q = 0; q < 4; ++q) { const int m = m0 + q * NGW; if (m < T) {
            u32x2* xb = (u32x2*)(XB + (size_t)m * D) + lane; float s = 0.f;
#pragma unroll
            for (int j = 0; j < 4; ++j) { const f32x4 w = v[q][j]; s += (w.x * w.x + w.y * w.y) + (w.z * w.z + w.w * w.w);
                u32x2 o; o.x = pk2(w.x, w.y); o.y = pk2(w.z, w.w); xb[64 * j] = o; }
            s = wave_sum(s);
            if (lane < 4) SS[(size_t)m * 4 + lane] = lane == 0 ? s : 0.f; } }
    }
}

template <int DIR, int MODE>
__device__ __forceinline__ void lru_dir(const Args& a, int l, int b, int ch, int w, int lane, const bf16x8 (&af)[4], const float (&xcr)[32], float (&hf)[32],
                                        LAS float* au, const bf16* wl, const float (&gl)[32], const float (&prm)[2][2][3]) {
    const int r32 = lane & 31, h = lane >> 5, c = w * 64 + lane;
    f32x16 accR[2], accI[2];
#pragma unroll
    for (int nt = 0; nt < 2; ++nt) {
#pragma unroll
        for (int i = 0; i < 16; ++i) { accR[nt][i] = 0.f; accI[nt][i] = 0.f; }
        const bf16* wr_ = wl + (size_t)((DIR * 8 + w) * 2) * 4096 + (nt * 32 + r32) * 64 + 8 * h;
#pragma unroll
        for (int ks = 0; ks < 4; ++ks) {
            const bf16x8 bR = *(const bf16x8*)(wr_ + 16 * ks), bI = *(const bf16x8*)(wr_ + 4096 + 16 * ks);
            accR[nt] = MFMA32(af[ks], bR, accR[nt]); accI[nt] = MFMA32(af[ks], bI, accI[nt]); }
    }
#pragma unroll
    for (int nt = 0; nt < 2; ++nt) {
        const float nba = prm[DIR][nt][0], nbx = prm[DIR][nt][1], k8l = prm[DIR][nt][2];
#pragma unroll
        for (int i = 0; i < 16; ++i) {
            const float d1 = 1.f + __builtin_amdgcn_exp2f(__builtin_fmaf(accR[nt][i], -1.4426950408889634f, nba));
            const float d2 = 1.f + __builtin_amdgcn_exp2f(__builtin_fmaf(accI[nt][i], -1.4426950408889634f, nbx));
            const float inv = __builtin_amdgcn_rcpf(d1 * d2), rr = inv * d2, ii = inv * d1;
            const float av = __builtin_amdgcn_exp2f(k8l * rr);
            accR[nt][i] = av; accI[nt][i] = __builtin_amdgcn_sqrtf(fmaxf(__builtin_fmaf(-av, av, 1.f), 0.f)) * ii; }
    }
    float hc = 0.f, ap = 1.f;
    if (MODE == 1) hc = ((const float*)(a.ws + WS_CAR))[(size_t)((b * NCH + ch) * 2 + DIR) * LW + c];
#pragma unroll
    for (int hh = 0; hh < 2; ++hh) {
        const int half = DIR == 0 ? hh : 1 - hh;
#pragma unroll
        for (int nt = 0; nt < 2; ++nt)
#pragma unroll
            for (int i = 0; i < 8; ++i) { const int tt = 8 * (i >> 2) + 4 * h + (i & 3);
                f32x2 v; v.x = accR[nt][8 * half + i]; v.y = accI[nt][8 * half + i];
                *(LAS f32x2*)(au + (tt * 64 + nt * 32 + r32) * 2) = v; }
        LDS_WAVE_SYNC();
#pragma unroll
        for (int s = 0; s < 16; ++s) {
            const int tt = DIR == 0 ? s : 15 - s, t = half * 16 + tt;
            const f32x2 v = *(const LAS f32x2*)(au + (tt * 64 + lane) * 2);
            hc = v.x * hc + v.y * xcr[t];
            if (MODE == 0) { ap *= v.x;
                ((unsigned*)(a.ws + WS_HP))[((size_t)DIR * T + (size_t)b * SEQ + ch * 32 + t) * LW + c] = pg8::cvt_pk_bf16(hc, ap); }
            if (MODE == 1) { if (DIR == 0) hf[t] = hc; else hf[t] = gl[t] * (hf[t] + hc); }
        }
        LDS_WAVE_SYNC();
    }
    if (MODE == 0) { f32x2 v; v.x = ap; v.y = hc; ((f32x2*)(a.ws + WS_TOT))[(size_t)((b * NCH + ch) * 2 + DIR) * LW + c] = v; }
}


__device__ __forceinline__ void carry_phase(const Args& a, int bx) {
    int tid_ = threadIdx.x; asm volatile("" : "+v"(tid_));
    const int gt = bx * NTHR + tid_;
    if (gt >= NB * 2 * LW) return;
    const int b = gt >> 10, dir = (gt >> 9) & 1, c = gt & 511;
    const f32x2* tot = (const f32x2*)(a.ws + WS_TOT); float* car = (float*)(a.ws + WS_CAR);
    float hc = 0.f;
#pragma unroll 1
    for (int j0 = 0; j0 < NCH; j0 += 32) {
        f32x2 v[32];
#pragma unroll
        for (int i = 0; i < 32; ++i) { const int j = j0 + i, cj = dir == 0 ? j : NCH - 1 - j; v[i] = tot[(size_t)((b * NCH + cj) * 2 + dir) * LW + c]; }
#pragma unroll
        for (int i = 0; i < 32; ++i) { const int j = j0 + i, cj = dir == 0 ? j : NCH - 1 - j; car[(size_t)((b * NCH + cj) * 2 + dir) * LW + c] = hc; hc = v[i].x * hc + v[i].y; }
    }
}

template <int MODE>
__device__ __forceinline__ void lru_unit(const Args& a, int l, int b, int ch, LAS unsigned char* lds) {
    int tid_ = threadIdx.x; asm volatile("" : "+v"(tid_));
    const int tid = tid_, w = __builtin_amdgcn_readfirstlane(tid >> 6), lane = tid & 63, r32 = lane & 31, h = lane >> 5;
    const int c = w * 64 + lane, t0 = ch * 32;
    const bf16* proj = (const bf16*)(a.ws + WS_PROJ);
    LAS unsigned char* xcb = lds + w * 12800;
    LAS float* au = (LAS float*)(lds + w * 12800 + 4608);
    const float* cw = a.in[7] + (size_t)l * 4 * LW;
    const float cw0 = cw[c], cw1 = cw[LW + c], cw2 = cw[2 * LW + c], cw3 = cw[3 * LW + c], cb = a.in[8][l * LW + c];
    float prm[2][2][3];
#pragma unroll
    for (int d = 0; d < 2; ++d)
#pragma unroll
        for (int nt = 0; nt < 2; ++nt) { const int cc = (l * 2 + d) * LW + w * 64 + nt * 32 + r32;
            prm[d][nt][0] = a.in[10][cc]; prm[d][nt][1] = a.in[12][cc]; prm[d][nt][2] = a.in[13][cc]; }
    const bf16* xp = proj + (size_t)b * SEQ * DIN + c;
    float xin[35], gl[32];
    unsigned short xraw[35], graw[32];
#pragma unroll
    for (int i = 0; i < 35; ++i) { const int t = t0 - 2 + i, tc = t < 0 ? 0 : (t >= SEQ ? SEQ - 1 : t); xraw[i] = xp[(size_t)tc * DIN]; }
    if (MODE == 1) {
#pragma unroll
        for (int t = 0; t < 32; ++t) graw[t] = xp[(size_t)(t0 + t) * DIN + LW];
    }
    asm volatile("" ::: "memory");
#pragma unroll
    for (int i = 0; i < 35; ++i) { const int t = t0 - 2 + i; xin[i] = (t >= 0 && t < SEQ) ? bf2f(xraw[i]) : 0.f; }
    if (MODE == 1) {
#pragma unroll
        for (int t = 0; t < 32; ++t) gl[t] = gelu_tanh(bf2f(graw[t]));
    }
    float xcr[32], hf[32];
#pragma unroll
    for (int t = 0; t < 32; ++t) { const float xc = cw0 * xin[t] + cw1 * xin[t + 1] + cw2 * xin[t + 2] + cw3 * xin[t + 3] + cb; xcr[t] = xc; hf[t] = 0.f;
        *(LAS bf16*)(xcb + t * 144 + lane * 2) = (bf16)f2bf(xc); }
#pragma unroll
    for (int d = 0; d < 2; ++d)
#pragma unroll
        for (int nt = 0; nt < 2; ++nt) { prm[d][nt][0] *= -1.4426950408889634f; prm[d][nt][1] *= -1.4426950408889634f;
            prm[d][nt][2] = -8.f * 1.4426950408889634f * log1pf(__expf(-prm[d][nt][2])); }
    LDS_WAVE_SYNC();
    bf16x8 af[4];
#pragma unroll
    for (int ks = 0; ks < 4; ++ks) af[ks] = *(const LAS bf16x8*)(xcb + r32 * 144 + (16 * ks + 8 * h) * 2);
    const bf16* wl = (const bf16*)(a.ws + WS_W) + (size_t)l * W_LAYER + W_LRU;
    lru_dir<0, MODE>(a, l, b, ch, w, lane, af, xcr, hf, au, wl, gl, prm);
    lru_dir<1, MODE>(a, l, b, ch, w, lane, af, xcr, hf, au, wl, gl, prm);
    if (MODE == 1) {
        __syncthreads();
        LAS float* yp = (LAS float*)lds;
#pragma unroll
        for (int t = 0; t < 32; ++t) yp[t * LW + c] = hf[t];
        __syncthreads();
        const float* gn = a.in[16] + l * LW + lane * 8;
        const f32x4 g0 = *(const f32x4*)gn, g1 = *(const f32x4*)(gn + 4);
        bf16* Y = (bf16*)(a.ws + WS_Y);
#pragma unroll
        for (int i = 0; i < 4; ++i) { const int t = w * 4 + i;
            const f32x4 v0 = *(const LAS f32x4*)(yp + t * LW + lane * 8), v1 = *(const LAS f32x4*)(yp + t * LW + lane * 8 + 4);
            float s = (v0.x * v0.x + v0.y * v0.y) + (v0.z * v0.z + v0.w * v0.w) + (v1.x * v1.x + v1.y * v1.y) + (v1.z * v1.z + v1.w * v1.w);
            s = wave_sum(s); const float rs = __builtin_amdgcn_rsqf(s * (1.f / 512.f) + 1e-6f);
            u32x4 o; o.x = pk2(v0.x * rs * g0.x, v0.y * rs * g0.y); o.y = pk2(v0.z * rs * g0.z, v0.w * rs * g0.w);
            o.z = pk2(v1.x * rs * g1.x, v1.y * rs * g1.y); o.w = pk2(v1.z * rs * g1.z, v1.w * rs * g1.w);
            *(u32x4*)(Y + ((size_t)b * SEQ + t0 + t) * D + lane * 8) = o; }
    }
}


__device__ __forceinline__ void lru_finish(const Args& a, int l, int gw, int NGW, int lane) {
    const bf16* proj = (const bf16*)(a.ws + WS_PROJ); const unsigned* HP = (const unsigned*)(a.ws + WS_HP); const float* CAR = (const float*)(a.ws + WS_CAR);
    bf16* Y = (bf16*)(a.ws + WS_Y);
    const float* gn = a.in[16] + l * LW + lane * 8;
    const f32x4 gn0 = *(const f32x4*)gn, gn1 = *(const f32x4*)(gn + 4);
#pragma unroll 1
    for (int row = gw; row < T; row += NGW) {
        const int b = row >> 12, ch = (row & (SEQ - 1)) >> 5;
        const unsigned* hpf = HP + (size_t)row * LW + lane * 8; const unsigned* hpb = hpf + (size_t)T * LW;
        const float* cf = CAR + (size_t)((b * NCH + ch) * 2) * LW + lane * 8; const float* cb = cf + LW;
        const u32x4 f0 = *(const u32x4*)hpf, f1 = *(const u32x4*)(hpf + 4), b0 = *(const u32x4*)hpb, b1 = *(const u32x4*)(hpb + 4);
        const u32x4 gq = *(const u32x4*)(proj + (size_t)row * DIN + LW + lane * 8);
        const f32x4 cf0 = *(const f32x4*)cf, cf1 = *(const f32x4*)(cf + 4), cb0 = *(const f32x4*)cb, cb1 = *(const f32x4*)(cb + 4);
        asm volatile("" ::: "memory");
        float y[8]; float s = 0.f;
#pragma unroll
        for (int i = 0; i < 8; ++i) {
            const unsigned fw = i < 4 ? f0[i & 3] : f1[i & 3], bw = i < 4 ? b0[i & 3] : b1[i & 3], gw2 = gq[i >> 1];
            const float cfi = i < 4 ? cf0[i & 3] : cf1[i & 3], cbi = i < 4 ? cb0[i & 3] : cb1[i & 3];
            const float hlf = __builtin_bit_cast(float, fw << 16), pf_ = __builtin_bit_cast(float, fw & 0xffff0000u);
            const float hlb = __builtin_bit_cast(float, bw << 16), pb_ = __builtin_bit_cast(float, bw & 0xffff0000u);
            const float g = __builtin_bit_cast(float, (i & 1) ? (gw2 & 0xffff0000u) : (gw2 << 16));
            y[i] = gelu_tanh(g) * ((hlf + pf_ * cfi) + (hlb + pb_ * cbi)); s += y[i] * y[i]; }
        s = wave_sum(s); const float rs = __builtin_amdgcn_rsqf(s * (1.f / 512.f) + 1e-6f);
        u32x4 o; o.x = pk2(y[0] * rs * gn0.x, y[1] * rs * gn0.y); o.y = pk2(y[2] * rs * gn0.z, y[3] * rs * gn0.w);
        o.z = pk2(y[4] * rs * gn1.x, y[5] * rs * gn1.y); o.w = pk2(y[6] * rs * gn1.z, y[7] * rs * gn1.w);
        *(u32x4*)(Y + (size_t)row * D + lane * 8) = o;
    }
}


__device__ __forceinline__ void lru_finish2(const Args& a, int l, int bx, int G, LAS unsigned char* lds) {
    int tid_ = threadIdx.x; asm volatile("" : "+v"(tid_));
    const int tid = tid_, lane = tid & 63, wave = __builtin_amdgcn_readfirstlane(tid >> 6);
    const bf16* proj = (const bf16*)(a.ws + WS_PROJ); const unsigned* HP = (const unsigned*)(a.ws + WS_HP); const f32x2* tot = (const f32x2*)(a.ws + WS_TOT);
    bf16* Y = (bf16*)(a.ws + WS_Y);
    LAS float* car = (LAS float*)lds;
    const float* gn = a.in[16] + l * LW + lane * 8;
    const f32x4 gn0 = *(const f32x4*)gn, gn1 = *(const f32x4*)(gn + 4);
#pragma unroll 1
    for (int p = bx; p < NB * NCH / 2; p += G) {
        const int b = p / (NCH / 2), ch0 = 2 * (p % (NCH / 2)), ch1 = ch0 + 1;
        __syncthreads();
        { const int c = tid, nf = ch0, nb = NCH - 1 - ch1, nmax = nf > nb ? nf : nb;
          float hf = 0.f, hb = 0.f;
#pragma unroll 1
          for (int j0 = 0; j0 < nmax; j0 += 32) {
              f32x2 vf[32], vb[32];
#pragma unroll
              for (int i = 0; i < 32; ++i) { const int j = j0 + i, jf = j < nf ? j : 0, jb = j < nb ? NCH - 1 - j : NCH - 1;
                  vf[i] = tot[(size_t)((b * NCH + jf) * 2 + 0) * LW + c]; vb[i] = tot[(size_t)((b * NCH + jb) * 2 + 1) * LW + c]; }
              asm volatile("" ::: "memory");
#pragma unroll
              for (int i = 0; i < 32; ++i) { const int j = j0 + i;
                  if (j < nf) hf = vf[i].x * hf + vf[i].y;
                  if (j < nb) hb = vb[i].x * hb + vb[i].y; }
          }
          const f32x2 t0 = tot[(size_t)((b * NCH + ch0) * 2 + 0) * LW + c], t1 = tot[(size_t)((b * NCH + ch1) * 2 + 1) * LW + c];
          car[c] = hf; car[LW + c] = t0.x * hf + t0.y; car[3 * LW + c] = hb; car[2 * LW + c] = t1.x * hb + t1.y; }
        __syncthreads();
#pragma unroll 1
        for (int it = 0; it < 2; ++it) {
            u32x4 f0[4], f1[4], b0[4], b1[4], gq[4];
#pragma unroll
            for (int q = 0; q < 4; ++q) { const int rl = wave * 8 + it * 4 + q; const size_t row = (size_t)b * SEQ + ch0 * 32 + rl;
                const unsigned* hpf = HP + row * LW + lane * 8; const unsigned* hpb = hpf + (size_t)T * LW;
                f0[q] = *(const u32x4*)hpf; f1[q] = *(const u32x4*)(hpf + 4); b0[q] = *(const u32x4*)hpb; b1[q] = *(const u32x4*)(hpb + 4);
                gq[q] = *(const u32x4*)(proj + row * DIN + LW + lane * 8); }
            asm volatile("" ::: "memory");
#pragma unroll
            for (int q = 0; q < 4; ++q) { const int rl = wave * 8 + it * 4 + q, k = rl >> 5; const size_t row = (size_t)b * SEQ + ch0 * 32 + rl;
                const f32x4 cf0 = *(const LAS f32x4*)(car + k * LW + lane * 8), cf1 = *(const LAS f32x4*)(car + k * LW + lane * 8 + 4);
                const f32x4 cb0 = *(const LAS f32x4*)(car + (2 + k) * LW + lane * 8), cb1 = *(const LAS f32x4*)(car + (2 + k) * LW + lane * 8 + 4);
                float y[8]; float s = 0.f;
#pragma unroll
                for (int i = 0; i < 8; ++i) {
                    const unsigned fw = i < 4 ? f0[q][i & 3] : f1[q][i & 3], bw = i < 4 ? b0[q][i & 3] : b1[q][i & 3], gw2 = gq[q][i >> 1];
                    const float cfi = i < 4 ? cf0[i & 3] : cf1[i & 3], cbi = i < 4 ? cb0[i & 3] : cb1[i & 3];
                    const float hlf = __builtin_bit_cast(float, fw << 16), pf_ = __builtin_bit_cast(float, fw & 0xffff0000u);
                    const float hlb = __builtin_bit_cast(float, bw << 16), pb_ = __builtin_bit_cast(float, bw & 0xffff0000u);
                    const float g = __builtin_bit_cast(float, (i & 1) ? (gw2 & 0xffff0000u) : (gw2 << 16));
                    y[i] = gelu_tanh(g) * ((hlf + pf_ * cfi) + (hlb + pb_ * cbi)); s += y[i] * y[i]; }
                s = wave_sum(s); const float rs = __builtin_amdgcn_rsqf(s * (1.f / 512.f) + 1e-6f);
                u32x4 o; o.x = pk2(y[0] * rs * gn0.x, y[1] * rs * gn0.y); o.y = pk2(y[2] * rs * gn0.z, y[3] * rs * gn0.w);
                o.z = pk2(y[4] * rs * gn1.x, y[5] * rs * gn1.y); o.w = pk2(y[6] * rs * gn1.z, y[7] * rs * gn1.w);
                *(u32x4*)(Y + row * D + lane * 8) = o; }
        }
    }
}

__device__ __forceinline__ void lru_finish3(const Args& a, int l, int bx, int G, LAS unsigned char* lds) {
    int tid_ = threadIdx.x; asm volatile("" : "+v"(tid_));
    const int tid = tid_, lane = tid & 63, wave = __builtin_amdgcn_readfirstlane(tid >> 6);
    const bf16* proj = (const bf16*)(a.ws + WS_PROJ); const unsigned* HP = (const unsigned*)(a.ws + WS_HP);
    bf16* Y = (bf16*)(a.ws + WS_Y);
    const float* gn = a.in[16] + l * LW + lane * 8;
    const f32x4 gn0 = *(const f32x4*)gn, gn1 = *(const f32x4*)(gn + 4);
#pragma unroll 1
    for (int p = bx; p < NB * NCH / 2; p += G) {
        const int b = p / (NCH / 2), ch0 = 2 * (p % (NCH / 2)), ch1 = ch0 + 1;
        const int kw = wave >> 2;
        const float* cfp = (const float*)(a.ws + WS_CAR) + (size_t)((b * NCH + ch0 + kw) * 2) * LW + lane * 8;
        const f32x4 cf0 = *(const f32x4*)cfp, cf1 = *(const f32x4*)(cfp + 4), cb0 = *(const f32x4*)(cfp + LW), cb1 = *(const f32x4*)(cfp + LW + 4);
#pragma unroll 1
        for (int it = 0; it < 2; ++it) {
            u32x4 f0[4], f1[4], b0[4], b1[4], gq[4];
#pragma unroll
            for (int q = 0; q < 4; ++q) { const int rl = wave * 8 + it * 4 + q; const size_t row = (size_t)b * SEQ + ch0 * 32 + rl;
                const unsigned* hpf = HP + row * LW + lane * 8; const unsigned* hpb = hpf + (size_t)T * LW;
                f0[q] = *(const u32x4*)hpf; f1[q] = *(const u32x4*)(hpf + 4); b0[q] = *(const u32x4*)hpb; b1[q] = *(const u32x4*)(hpb + 4);
                gq[q] = *(const u32x4*)(proj + row * DIN + LW + lane * 8); }
            asm volatile("" ::: "memory");
#pragma unroll
            for (int q = 0; q < 4; ++q) { const int rl = wave * 8 + it * 4 + q; const size_t row = (size_t)b * SEQ + ch0 * 32 + rl;
                float y[8]; float s = 0.f;
#pragma unroll
                for (int i = 0; i < 8; ++i) {
                    const unsigned fw = i < 4 ? f0[q][i & 3] : f1[q][i & 3], bw = i < 4 ? b0[q][i & 3] : b1[q][i & 3], gw2 = gq[q][i >> 1];
                    const float cfi = i < 4 ? cf0[i & 3] : cf1[i & 3], cbi = i < 4 ? cb0[i & 3] : cb1[i & 3];
                    const float hlf = __builtin_bit_cast(float, fw << 16), pf_ = __builtin_bit_cast(float, fw & 0xffff0000u);
                    const float hlb = __builtin_bit_cast(float, bw << 16), pb_ = __builtin_bit_cast(float, bw & 0xffff0000u);
                    const float g = __builtin_bit_cast(float, (i & 1) ? (gw2 & 0xffff0000u) : (gw2 << 16));
                    y[i] = gelu_tanh(g) * ((hlf + pf_ * cfi) + (hlb + pb_ * cbi)); s += y[i] * y[i]; }
                s = wave_sum(s); const float rs = __builtin_amdgcn_rsqf(s * (1.f / 512.f) + 1e-6f);
                u32x4 o; o.x = pk2(y[0] * rs * gn0.x, y[1] * rs * gn0.y); o.y = pk2(y[2] * rs * gn0.z, y[3] * rs * gn0.w);
                o.z = pk2(y[4] * rs * gn1.x, y[5] * rs * gn1.y); o.w = pk2(y[6] * rs * gn1.z, y[7] * rs * gn1.w);
                *(u32x4*)(Y + row * D + lane * 8) = o; }
        }
    }
}

constexpr int AT_BIAS = 0, AT_RED = 8448, AT_K = 9472, KPITCH = 72, AT_V = AT_K + 320 * KPITCH * 2;
typedef short v4i16_t __attribute__((ext_vector_type(4)));
__device__ __forceinline__ bf16x8 vtr8(const LAS unsigned char* p) {
    const v4i16_t lo = __builtin_amdgcn_ds_read_tr16_b64_v4i16((LAS v4i16_t*)p), hi = __builtin_amdgcn_ds_read_tr16_b64_v4i16((LAS v4i16_t*)(p + 8 * KPITCH * 2));
    return __builtin_shufflevector(lo, hi, 0, 1, 2, 3, 4, 5, 6, 7);
}
__device__ __forceinline__ void attn_unit(const Args& a, int l, int b, int qb, LAS unsigned char* lds) {
    int tid_ = threadIdx.x; asm volatile("" : "+v"(tid_));
    const int tid = tid_, w = __builtin_amdgcn_readfirstlane(tid >> 6), lane = tid & 63, r32 = lane & 31, h = lane >> 5;
    const bf16* proj = (const bf16*)(a.ws + WS_PROJ);
    const LAS float* btab = (const LAS float*)(lds + LDS_BTAB); LAS float* red = (LAS float*)(lds + AT_RED); LAS bf16* Kl = (LAS bf16*)(lds + AT_K); LAS bf16* Vl = (LAS bf16*)(lds + AT_V);
    const size_t rowb = (size_t)b * SEQ; const int q0 = qb * 64, kw0 = q0 - 128;
    const int mt = w & 1, hq = w >> 1, qpos = q0 + mt * 32 + r32;
    const int trofs = (4 * h + ((lane & 15) >> 2)) * (KPITCH * 2) + 32 * ((lane >> 4) & 1) + 8 * (lane & 3);
    f32x16 O[2][2];
#pragma unroll
    for (int kvh = 0; kvh < 2; ++kvh) {
        const int head = kvh * 4 + hq;
        __syncthreads();
        bf16x8 qf[4];
        const float sink_raw = a.in[14][l * 8 + head];
        { u32x4 kq[5], vq[5];
#pragma unroll
          for (int q = 0; q < 5; ++q) { const int it = tid + q * NTHR, key = it >> 3, dc = it & 7, kp = kw0 + key, kc = kp < 0 ? 0 : (kp >= SEQ ? SEQ - 1 : kp);
              const bf16* src = proj + (rowb + kc) * DIN + 1536 + kvh * 64 + dc * 8; kq[q] = *(const u32x4*)src; vq[q] = *(const u32x4*)(src + 128); }
#pragma unroll
          for (int ks = 0; ks < 4; ++ks) qf[ks] = *(const bf16x8*)(proj + (rowb + qpos) * DIN + 1024 + head * 64 + 16 * ks + 8 * h);
          asm volatile("" ::: "memory");
#pragma unroll
          for (int q = 0; q < 5; ++q) { const int it = tid + q * NTHR, key = it >> 3, dc = it & 7, kp = kw0 + key; const bool in = kp >= 0 && kp < SEQ;
              const u32x4 z = (u32x4){0u, 0u, 0u, 0u};
              *(LAS u32x4*)(Kl + key * KPITCH + dc * 8) = in ? kq[q] : z; *(LAS u32x4*)(Vl + key * KPITCH + dc * 8) = in ? vq[q] : z; } }
        __syncthreads();
        const float sink = sink_raw * 1.4426950408889634f;
        float m = sink, lsum = 1.f;
#pragma unroll
        for (int dt = 0; dt < 2; ++dt)
#pragma unroll
            for (int i = 0; i < 16; ++i) O[kvh][dt][i] = 0.f;
        const LAS float* bT = btab + head * 384 + 192 + 4 * h - qpos;
#pragma unroll 1
        for (int jp = 0; jp < 5; ++jp) {
            const int kb0 = kw0 + 64 * jp;
            if (kb0 + 63 < 0 || kb0 >= SEQ) continue;
            f32x16 S0, S1;
#pragma unroll
            for (int i = 0; i < 16; ++i) { S0[i] = 0.f; S1[i] = 0.f; }
            const LAS bf16* kp0 = Kl + (jp * 64 + r32) * KPITCH + 8 * h;
#pragma unroll
            for (int ks = 0; ks < 4; ++ks) { const bf16x8 k0 = *(const LAS bf16x8*)(kp0 + 16 * ks), k1 = *(const LAS bf16x8*)(kp0 + 32 * KPITCH + 16 * ks);
                S0 = MFMA32(k0, qf[ks], S0); S1 = MFMA32(k1, qf[ks], S1); }
            float tmax = -1e30f;
            const LAS float* bp = bT + kb0;
#pragma unroll
            for (int i = 0; i < 16; ++i) {
                const float l0 = __builtin_fmaf(S0[i], 0.125f * 1.4426950408889634f, bp[(i & 3) + 8 * (i >> 2)]), l1 = __builtin_fmaf(S1[i], 0.125f * 1.4426950408889634f, bp[32 + (i & 3) + 8 * (i >> 2)]);
                S0[i] = l0; S1[i] = l1; tmax = fmaxf(tmax, fmaxf(l0, l1)); }
            tmax = fmaxf(tmax, __shfl_xor(tmax, 32));
            const float mnew = fmaxf(m, tmax), alpha = __builtin_amdgcn_exp2f(m - mnew);
            float psum = 0.f;
#pragma unroll
            for (int i = 0; i < 16; ++i) { const float p0 = __builtin_amdgcn_exp2f(S0[i] - mnew), p1 = __builtin_amdgcn_exp2f(S1[i] - mnew);
                S0[i] = p0; S1[i] = p1; psum += p0 + p1; }
            psum += __shfl_xor(psum, 32);
            lsum = lsum * alpha + psum; m = mnew;
            bf16x8 pf[4];
#pragma unroll
            for (int s2 = 0; s2 < 2; ++s2) { u32x4 p; p.x = pg8::cvt_pk_bf16(S0[8 * s2], S0[8 * s2 + 1]); p.y = pg8::cvt_pk_bf16(S0[8 * s2 + 2], S0[8 * s2 + 3]); p.z = pg8::cvt_pk_bf16(S0[8 * s2 + 4], S0[8 * s2 + 5]); p.w = pg8::cvt_pk_bf16(S0[8 * s2 + 6], S0[8 * s2 + 7]);
                pf[s2] = __builtin_bit_cast(bf16x8, p);
                p.x = pg8::cvt_pk_bf16(S1[8 * s2], S1[8 * s2 + 1]); p.y = pg8::cvt_pk_bf16(S1[8 * s2 + 2], S1[8 * s2 + 3]); p.z = pg8::cvt_pk_bf16(S1[8 * s2 + 4], S1[8 * s2 + 5]); p.w = pg8::cvt_pk_bf16(S1[8 * s2 + 6], S1[8 * s2 + 7]);
                pf[2 + s2] = __builtin_bit_cast(bf16x8, p); }
            const bool resc = __builtin_amdgcn_ballot_w64(alpha != 1.f) != 0;
            const LAS unsigned char* vb = (const LAS unsigned char*)Vl + (jp * 64) * (KPITCH * 2) + trofs;
#pragma unroll
            for (int dt = 0; dt < 2; ++dt) {
                if (resc) {
#pragma unroll
                    for (int i = 0; i < 16; ++i) O[kvh][dt][i] *= alpha; }
#pragma unroll
                for (int s4 = 0; s4 < 4; ++s4) { const bf16x8 vf = vtr8(vb + (16 * s4) * (KPITCH * 2) + dt * 64);
                    O[kvh][dt] = MFMA32(vf, pf[s4], O[kvh][dt]); }
            }
        }
        const float inv = __builtin_amdgcn_rcpf(lsum);
#pragma unroll
        for (int dt = 0; dt < 2; ++dt)
#pragma unroll
            for (int i = 0; i < 16; ++i) O[kvh][dt][i] *= inv;
    }
    const float* gn = a.in[17] + l * 512;
    f32x4 gv[2][2][4];
#pragma unroll
    for (int kvh = 0; kvh < 2; ++kvh)
#pragma unroll
        for (int dt = 0; dt < 2; ++dt)
#pragma unroll
            for (int g4 = 0; g4 < 4; ++g4) gv[kvh][dt][g4] = *(const f32x4*)(gn + (kvh * 4 + hq) * 64 + dt * 32 + 8 * g4 + 4 * h);
    asm volatile("" ::: "memory");
    float ssq = 0.f;
#pragma unroll
    for (int kvh = 0; kvh < 2; ++kvh)
#pragma unroll
        for (int dt = 0; dt < 2; ++dt)
#pragma unroll
            for (int i = 0; i < 16; ++i) ssq += O[kvh][dt][i] * O[kvh][dt][i];
    ssq += __shfl_xor(ssq, 32);
    if (h == 0) red[w * 32 + r32] = ssq;
    __syncthreads();
    const float tot = (red[mt * 32 + r32] + red[(mt + 2) * 32 + r32]) + (red[(mt + 4) * 32 + r32] + red[(mt + 6) * 32 + r32]);
    const float rs = __builtin_amdgcn_rsqf(tot * (1.f / 512.f) + 1e-6f);
    bf16* Y = (bf16*)(a.ws + WS_Y) + (rowb + qpos) * D + 512;
#pragma unroll
    for (int kvh = 0; kvh < 2; ++kvh)
#pragma unroll
        for (int dt = 0; dt < 2; ++dt)
#pragma unroll
            for (int g4 = 0; g4 < 4; ++g4) { const int col = (kvh * 4 + hq) * 64 + dt * 32 + 8 * g4 + 4 * h;
                const f32x4 g = gv[kvh][dt][g4];
                u32x2 o; o.x = pk2(O[kvh][dt][4 * g4] * rs * g.x, O[kvh][dt][4 * g4 + 1] * rs * g.y); o.y = pk2(O[kvh][dt][4 * g4 + 2] * rs * g.z, O[kvh][dt][4 * g4 + 3] * rs * g.w);
                *(u32x2*)(Y + col) = o; }
}

#define XB_TMO      128
#define XB_XCNT(j)  (256  + 64 * (j))
#define XB_XSUB(j)  (1280 + 64 * (j))
#define XB_XGEN(j)  (2304 + 64 * (j))
#define XB_TOP      3328
#define XB_TOPGEN   3392
#define XCD_BAR_WORDS 3456
#define XB_SPIN_CAP (1u << 18)

__device__ __forceinline__ unsigned xb_ld(unsigned* p)              { return __hip_atomic_load(p, __ATOMIC_RELAXED, __HIP_MEMORY_SCOPE_AGENT); }
__device__ __forceinline__ unsigned xb_add(unsigned* p, unsigned v) { return __hip_atomic_fetch_add(p, v, __ATOMIC_RELAXED, __HIP_MEMORY_SCOPE_AGENT); }
__device__ __forceinline__ unsigned xb_xcc_id() { return (unsigned)__builtin_amdgcn_s_getreg((3 << 11) | 20) & 0xFu; }
#define XB_SPIN(cond, bar) do { unsigned _sp = 0; while (cond) { __builtin_amdgcn_s_sleep(1); \
    if ((++_sp & 255u) == 0u) { if (xb_ld(&(bar)[XB_TMO])) break; if (_sp > XB_SPIN_CAP) { atomicAdd(&(bar)[XB_TMO], 1u); break; } } } } while (0)

struct XcdBarrier {
    unsigned* bar; unsigned x;
    volatile LAS unsigned* st;
};

__device__ __forceinline__ XcdBarrier xcd_barrier_post(unsigned* bar, volatile LAS unsigned* st) {
    XcdBarrier b; b.bar = bar; b.x = xb_xcc_id(); b.st = st;
    if (threadIdx.x == 0) (void)xb_add(&bar[XB_XCNT(b.x)], 1u);
    return b;
}
__device__ __forceinline__ void xcd_barrier_complete(unsigned* bar, unsigned x, unsigned& nloc, unsigned& nx) {
    const unsigned G = gridDim.x * gridDim.y * gridDim.z;
    unsigned sum, cnt, mine, sp = 0u;
    for (;;) {
        sum = 0u; cnt = 0u; mine = 0u;
#pragma unroll
        for (unsigned j = 0; j < 16; ++j) { const unsigned c = xb_ld(&bar[XB_XCNT(j)]); sum += c; cnt += (c > 0u) ? 1u : 0u; mine = (j == x) ? c : mine; }
        if (sum == G) break;
        __builtin_amdgcn_s_sleep(1);
        if ((++sp & 255u) == 0u) { if (xb_ld(&bar[XB_TMO])) break; if (sp > XB_SPIN_CAP) { atomicAdd(&bar[XB_TMO], 1u); break; } }
    }
    nloc = mine > 0u ? mine : 1u; nx = cnt > 0u ? cnt : 1u;
}

__device__ __forceinline__ void xcd_barrier(const XcdBarrier& b) {
    asm volatile("s_waitcnt vmcnt(0)" ::: "memory");
    __syncthreads();
    if (threadIdx.x == 0) {
        unsigned* bar = b.bar;
        __builtin_amdgcn_s_waitcnt(0);
        unsigned nloc = b.st[0], nx = b.st[1];
        if (nloc == 0u) { xcd_barrier_complete(bar, b.x, nloc, nx); b.st[0] = nloc; b.st[1] = nx; }
        const unsigned old = xb_add(&bar[XB_XSUB(b.x)], 1u);
        const unsigned gen = old / nloc;
        if (old + 1u == (gen + 1u) * nloc) {
            __builtin_amdgcn_fence(__ATOMIC_RELEASE, "agent");
            asm volatile("s_waitcnt vmcnt(0)" ::: "memory");
            const unsigned og = xb_add(&bar[XB_TOP], 1u);
            const unsigned tg = og / nx;
            if (og + 1u == (tg + 1u) * nx) xb_add(&bar[XB_TOPGEN], 1u);
            else XB_SPIN(xb_ld(&bar[XB_TOPGEN]) == tg, bar);
            __builtin_amdgcn_fence(__ATOMIC_ACQUIRE, "agent");
            xb_add(&bar[XB_XGEN(b.x)], 1u);
            asm volatile("s_waitcnt vmcnt(0)" ::: "memory");
        } else {
            XB_SPIN(xb_ld(&bar[XB_XGEN(b.x)]) == gen, bar);
            __builtin_amdgcn_fence(__ATOMIC_ACQUIRE, "agent");
            asm volatile("s_waitcnt vmcnt(0)" ::: "memory");
        }
    }
    __syncthreads();
}

__global__ void __launch_bounds__(NTHR, 2) mega_fwd(Args a) {
    extern __shared__ __attribute__((aligned(16))) unsigned char lds_raw[];
    LAS unsigned char* lds = (LAS unsigned char*)lds_raw;
    cg::grid_group grid = cg::this_grid();
    const int G = gridDim.x, bx = blockIdx.x, NGW = G * NWAVES;
    bf16* XB = (bf16*)(a.ws + WS_XB); bf16* HB = (bf16*)(a.ws + WS_H); bf16* PROJ = (bf16*)(a.ws + WS_PROJ); bf16* Y = (bf16*)(a.ws + WS_Y);
    float* SS = (float*)(a.ws + WS_SS);
    grid.sync();
    if (threadIdx.x < 2) ((volatile LAS unsigned*)(lds + 131072))[threadIdx.x] = 0u;
    for (int i = threadIdx.x; i < 8 * 384; i += NTHR) {
        const int hh = i / 384, rel = i % 384 - 192, n = rel < 0 ? -rel : rel; int bk = rel > 0 ? 16 : 0;
        if (n < 8) bk += n; else { int k = 8 + (31 - __builtin_clz(n * n)) - 6; bk += k < 15 ? k : 15; }
        ((LAS float*)(lds + LDS_BTAB))[i] = n <= 128 ? a.in[15][bk * 8 + hh] * 1.4426950408889634f : -1e30f; }
    __syncthreads();
    const XcdBarrier xbar = xcd_barrier_post((unsigned*)a.ws, (volatile LAS unsigned*)(lds + 131072));
#define GSYNC() do { _Pragma("unroll 1") for (int sy_ = 0; sy_ < PROBE_SYNCREP; ++sy_) xcd_barrier(xbar); } while (0)

#pragma unroll 1
    for (int rep = 0; rep < PROBE_PROREP; ++rep)
    { int tid_ = threadIdx.x; asm volatile("" : "+v"(tid_)); const int lane = tid_ & 63, wave = __builtin_amdgcn_readfirstlane(tid_ >> 6);
      _Pragma("unroll 1") for (int cl = 0; cl < (PROBE_NOTAIL ? DEPTH : 1); ++cl) convert_items(a, lds, cl, 0, PER, bx * NWAVES + wave, NGW, wave, lane);
      x_prologue(a, bx * NWAVES + wave, NGW, lane); }
    GSYNC();
    for (int l = 0; l < DEPTH; ++l) {
        const bf16* wl = (const bf16*)(a.ws + WS_W) + (size_t)l * W_LAYER;
#pragma unroll 1
        for (int f = 0; f < 2; ++f) {
            if (f == 1) {
                { pg8::Gemm g{XB, wl + W_IN, T, DIN, D}; pg8::StaticOrder S; S.init(T, DIN, G, bx); pg8::EpiProj E{PROJ, SS};
                  pg8::gemm_phase<pg8::EpiProj, pg8::StaticOrder, true, true>(lds, g, S, E); }
                GSYNC();
#pragma unroll 1
                for (int rep = 0; rep < PROBE_MIXREP; ++rep) {
#pragma unroll 1
                for (int u = bx; u < 256 + NB * NCH; u += G) {
                    __syncthreads();
                    if (u < 256) { _Pragma("unroll 1") for (int rp = 0; rp < PROBE_ATTNREP; ++rp) { attn_unit(a, l, u >> 6, u & 63, lds); __syncthreads(); } }
                    else { const int v = u - 256; _Pragma("unroll 1") for (int rp = 0; rp < PROBE_D1REP; ++rp) lru_unit<0>(a, l, v / NCH, v % NCH, lds); }
                }
                GSYNC();
                carry_phase(a, bx);
                GSYNC();
                _Pragma("unroll 1") for (int rp = 0; rp < PROBE_D2REP; ++rp) lru_finish3(a, l, bx, G, lds);
                GSYNC();
                }
                { pg8::Gemm g{Y, wl + W_OUT, T, D, D}; pg8::StaticOrder S; S.init(T, D, G, bx); pg8::EpiRes E{XB, SS, 1.0f, (LAS float*)(lds + 131072 + 256)};
                  pg8::gemm_phase<pg8::EpiRes, pg8::StaticOrder, true, true>(lds, g, S, E); }
                GSYNC();
            }
#pragma unroll 1
            for (int rp = 0; rp < PROBE_GUREP; ++rp)
            { pg8::Gemm g{XB, wl + (f ? W_GU2 : W_GU1), T, NGU, D}; pg8::StaticOrder S; S.init(T, NGU, G, bx); pg8::EpiSwiglu E{HB, SS};
              pg8::gemm_phase<pg8::EpiSwiglu, pg8::StaticOrder, true, true>(lds, g, S, E); }
            { const int first = ((T / 256) * (NGU / 256)) % G, nidle = G - first;
              if (!PROBE_NOTAIL && l + 1 < DEPTH && bx >= first) { int tid_ = threadIdx.x; asm volatile("" : "+v"(tid_)); const int lane = tid_ & 63, wave = __builtin_amdgcn_readfirstlane(tid_ >> 6);
                  convert_items(a, lds, l + 1, f ? PER / 2 : 0, f ? PER : PER / 2, (bx - first) * NWAVES + wave, nidle * NWAVES, wave, lane); } }
            GSYNC();
            { pg8::Gemm g{HB, wl + (f ? W_D2 : W_D1), T, D, FF}; pg8::StaticOrder S; S.init(T, D, G, bx); pg8::EpiRes E{XB, SS, 0.5f, (LAS float*)(lds + 131072 + 256)};
              pg8::gemm_phase<pg8::EpiRes, pg8::StaticOrder, true, true>(lds, g, S, E); }
            GSYNC();
        }
    }
    int tid_ = threadIdx.x; asm volatile("" : "+v"(tid_)); const int lane = tid_ & 63, gw = bx * NWAVES + __builtin_amdgcn_readfirstlane(tid_ >> 6);
    const float* gp = a.in[23] + lane * 8;
    const f32x4 g0 = *(const f32x4*)gp, g1 = *(const f32x4*)(gp + 4), g2 = *(const f32x4*)(gp + 512), g3 = *(const f32x4*)(gp + 516);
#pragma unroll 1
    for (int m0 = gw; m0 < T; m0 += 4 * NGW) {
        u32x4 v[4][2];
#pragma unroll
        for (int q = 0; q < 4; ++q) { const int m = m0 + q * NGW, mc = m < T ? m : gw; const u32x4* xr = (const u32x4*)(XB + (size_t)mc * D) + lane; v[q][0] = xr[0]; v[q][1] = xr[64]; }
        asm volatile("" ::: "memory");
#pragma unroll
        for (int q = 0; q < 4; ++q) { const int m = m0 + q * NGW; if (m < T) {
            f32x4 x[4]; float s = 0.f;
#pragma unroll
            for (int j = 0; j < 2; ++j) { const u32x4 o = v[q][j];
                x[2 * j] = (f32x4){__builtin_bit_cast(float, o.x << 16), __builtin_bit_cast(float, o.x & 0xffff0000u), __builtin_bit_cast(float, o.y << 16), __builtin_bit_cast(float, o.y & 0xffff0000u)};
                x[2 * j + 1] = (f32x4){__builtin_bit_cast(float, o.z << 16), __builtin_bit_cast(float, o.z & 0xffff0000u), __builtin_bit_cast(float, o.w << 16), __builtin_bit_cast(float, o.w & 0xffff0000u)}; }
#pragma unroll
            for (int j = 0; j < 4; ++j) s += (x[j].x * x[j].x + x[j].y * x[j].y) + (x[j].z * x[j].z + x[j].w * x[j].w);
            const float rs = __builtin_amdgcn_rsqf(wave_sum(s) * (1.f / D) + 1e-6f);
            float* orow = a.out + (size_t)m * D + lane * 8;
            *(f32x4*)orow = x[0] * rs * g0; *(f32x4*)(orow + 4) = x[1] * rs * g1; *(f32x4*)(orow + 512) = x[2] * rs * g2; *(f32x4*)(orow + 516) = x[3] * rs * g3; } }
    }
}

extern "C" void kernel_launch(void* const* d_in, const int* in_sizes, int n_in, void* d_out, int out_size, void* d_ws, size_t ws_size, hipStream_t stream) {
    static int grid = 0;
    if (grid == 0) {
        if (n_in != 24 || in_sizes[0] != T * D || out_size != T * D || ws_size < WS_END) { fprintf(stderr, "kernel_launch: unexpected shapes (n_in %d, in0 %d, out %d, ws %zu)\n", n_in, n_in > 0 ? in_sizes[0] : -1, out_size, ws_size); grid = -1; return; }
        int dev = 0, cus = 0, per_cu = 0;
        hipGetDevice(&dev); hipDeviceGetAttribute(&cus, hipDeviceAttributeMultiprocessorCount, dev);
        hipFuncSetAttribute((const void*)mega_fwd, hipFuncAttributeMaxDynamicSharedMemorySize, LDS_BYTES);
        hipOccupancyMaxActiveBlocksPerMultiprocessor(&per_cu, (const void*)mega_fwd, NTHR, LDS_BYTES);
        if (per_cu < 1) per_cu = 1;
        (void)hipGetLastError();
        grid = cus * per_cu;
        fprintf(stderr, "kernel_launch: %d CUs x %d = grid %d\n", cus, per_cu, grid);
    }
    if (grid < 0) return;
    Args a{};
    for (int i = 0; i < 24; ++i) a.in[i] = (const float*)d_in[i];
    a.out = (float*)d_out; a.ws = (unsigned char*)d_ws; a.coop = 1; a.pad = 0;
    if (hipMemsetAsync(d_ws, 0, 65536, stream) != hipSuccess) { fprintf(stderr, "kernel_launch: memset of the barrier words failed\n"); return; }
    void* args[] = {&a};
    hipError_t e = hipLaunchCooperativeKernel((const void*)mega_fwd, dim3(grid), dim3(NTHR), args, LDS_BYTES, stream);
    if (e != hipSuccess) fprintf(stderr, "cooperative launch failed: %s (grid %d)\n", hipGetErrorString(e), grid);
}
```

```cpp
#include <hip/hip_runtime.h>
#include <hip/hip_cooperative_groups.h>
#include <cstdio>
#include <cstdint>
namespace cg = cooperative_groups;
#define PROBE_MIXREP 1
#define PROBE_SYNCREP 1
#define PROBE_PROREP 1
#define PROBE_ATTNREP 1
#define PROBE_D1REP 1
#define PROBE_D2REP 1
#define PROBE_GUREP 1
#define PROBE_NOTAIL 0
namespace pg8 {
#define PG8_LAS __attribute__((address_space(3)))
typedef unsigned short bf16_t;
typedef short bf16x8 __attribute__((ext_vector_type(8)));
typedef float f32x4 __attribute__((ext_vector_type(4)));
typedef unsigned u32x4 __attribute__((ext_vector_type(4)));
constexpr int BM = 256, BK = 64, HALF = 128, HTB = HALF * BK * 2  , STAGE_BYTES = 8 * HTB, NXCD = 8, WGM = 8;

__host__ __device__ __forceinline__ int lds_byte(int r, int c) { const int st = (r >> 4) * 2 + (c >> 5), rr = r & 15, cc = c & 31, ob = rr * 64 + cc * 2; return st * 1024 + (ob ^ (((ob >> 9) & 1) << 5)); }
__host__ __device__ __forceinline__ void stage_rc(int b, int& R, int& C) { const int st = b / 1024, sb = b % 1024, swz = sb ^ (((sb >> 9) & 1) << 5); R = (st >> 1) * 16 + swz / 64; C = (st & 1) * 32 + (swz % 64) / 2; }
__host__ __device__ __forceinline__ int perm32(int rho) { const int n = rho >> 4, i = rho & 15; return 8 * (i >> 2) + 4 * n + (i & 3); }

struct Unit { int pm, pn; };
struct Gemm { const bf16_t* A; const bf16_t* Bt; int M, N, K; };

struct StaticOrder {
    int nM, nN, nwg, G, c;
    __host__ __device__ void init(int M, int N, int G_, int c_) { nM = M / BM; nN = N / BM; nwg = nM * nN; G = G_; c = c_; }
    __host__ __device__ bool next(int i, Unit& u) const {
        const long L = (long)i * G + c; if (L >= nwg) return false;
        int wgid = (int)L; { const int q = nwg / NXCD, r = nwg % NXCD, xcd = wgid % NXCD, off = wgid / NXCD; wgid = (xcd < r ? xcd * (q + 1) : r * (q + 1) + (xcd - r) * q) + off; }
        const int nig = WGM * nN, gid = wgid / nig, fm = gid * WGM, gsz = (nM - fm) < WGM ? (nM - fm) : WGM;
        u.pm = fm + ((wgid % nig) % gsz); u.pn = (wgid % nig) / gsz; return true;
    }
    __device__ __forceinline__ void a_ready(const Unit&) const {}
    __device__ __forceinline__ void done(const Unit&) const {}
};

__device__ __forceinline__ unsigned cvt_pk_bf16(float lo, float hi) { unsigned r; asm volatile("v_cvt_pk_bf16_f32 %0, %1, %2" : "=v"(r) : "v"(lo), "v"(hi)); return r; }
template <class Epi, class Sched, bool ALIGN_EPI = false, bool SP2 = false>
__device__ __forceinline__ void gemm_phase(PG8_LAS unsigned char* lds, const Gemm g, const Sched& S, const Epi& E) {
    int tid_ = threadIdx.x; asm volatile("" : "+v"(tid_));
    const int tid = tid_, wid = __builtin_amdgcn_readfirstlane(tid >> 6), lane = tid & 63, wr = wid >> 2, wc = wid & 3, fr = lane & 15, fq = lane >> 4;
    const int K = g.K, nt = K / BK;
    unsigned voffA[2], voffB[2];
#pragma unroll
    for (int i = 0; i < 2; ++i) { int R, C; stage_rc(tid * 16 + i * 8192, R, C); const int Rb = Epi::PERM ? ((R & ~31) + perm32(R & 31)) : R;
        voffA[i] = (unsigned)(R * K + C) * 2u; voffB[i] = (unsigned)(Rb * K + C) * 2u; }
    const size_t kstep = (size_t)(BK * 2);
    const size_t hstep = (size_t)HALF * K * 2;
    const size_t tstep = 2 * hstep;
    const unsigned ldsw = (unsigned)wid * 1024u;
    const int aoff = lds_byte(wr * 64 + fr, fq * 8), boff = lds_byte(wc * 32 + fr, fq * 8);
#define PG8_SA(b, h) (((b) * 2 + (h)) * HTB)
#define PG8_SB(b, h) ((4 + (b) * 2 + (h)) * HTB)
#define PG8_STAGE(bufoff, gbase, voff) do { _Pragma("unroll") for (int _i = 0; _i < 2; ++_i) \
        __builtin_amdgcn_global_load_lds((const unsigned*)((const char*)(gbase) + (voff)[_i]), (PG8_LAS unsigned*)(lds + (bufoff) + ldsw + _i * 8192), 16, 0, 0); } while (0)
#define PG8_LDA(dst, b, h) do { _Pragma("unroll") for (int m = 0; m < 4; ++m) _Pragma("unroll") for (int k = 0; k < 2; ++k) dst[m][k] = *(const PG8_LAS bf16x8*)(lds + PG8_SA(b, h) + aoff + m * 2048 + k * 1024); } while (0)
#define PG8_LDB(dst, b, h) do { _Pragma("unroll") for (int n = 0; n < 2; ++n) _Pragma("unroll") for (int k = 0; k < 2; ++k) dst[n][k] = *(const PG8_LAS bf16x8*)(lds + PG8_SB(b, h) + boff + n * 2048 + k * 1024); } while (0)
#define PG8_MMA(ai, bj, At, Bt) do { __builtin_amdgcn_s_setprio(1); _Pragma("unroll") for (int m = 0; m < 4; ++m) _Pragma("unroll") for (int n = 0; n < 2; ++n) _Pragma("unroll") for (int k = 0; k < 2; ++k) \
        acc[ai][bj][m][n] = __builtin_amdgcn_mfma_f32_16x16x32_bf16(Bt[n][k], At[m][k], acc[ai][bj][m][n], 0, 0, 0); __builtin_amdgcn_s_setprio(0); } while (0)
#define PG8_WAIT_V(n) asm volatile("s_waitcnt vmcnt(" #n ")" ::: "memory")
#define PG8_WAIT_L(n) asm volatile("s_waitcnt lgkmcnt(" #n ")" ::: "memory")
#define PG8_BAR __builtin_amdgcn_s_barrier()
#define PG8_SCHED __builtin_amdgcn_sched_barrier(0)
    Unit cur, nxt; int ui = 0;
    if (!S.next(0, cur)) return;
    f32x4 acc[2][2][4][2];
#pragma unroll
    for (int a = 0; a < 2; ++a)
#pragma unroll
        for (int b = 0; b < 2; ++b)
#pragma unroll
            for (int m = 0; m < 4; ++m)
#pragma unroll
                for (int n = 0; n < 2; ++n) acc[a][b][m][n] = (f32x4){0.f, 0.f, 0.f, 0.f};
    bf16x8 At[4][2], B0[2][2], B1[2][2];
    const char* cA = (const char*)g.A + (size_t)cur.pm * tstep; const char* cB = (const char*)g.Bt + (size_t)cur.pn * tstep;
    S.a_ready(cur);
    if constexpr (SP2) {
        PG8_STAGE(PG8_SB(0, 0), cB, voffB); PG8_STAGE(PG8_SB(0, 1), cB + hstep, voffB); PG8_STAGE(PG8_SA(0, 0), cA, voffA); PG8_STAGE(PG8_SA(0, 1), cA + hstep, voffA);
        if (wr == 1) PG8_BAR;
        PG8_WAIT_V(2); PG8_BAR;
        PG8_STAGE(PG8_SB(1, 0), cB + kstep, voffB); PG8_STAGE(PG8_SA(1, 0), cA + kstep, voffA); PG8_STAGE(PG8_SB(1, 1), cB + hstep + kstep, voffB);
        PG8_WAIT_V(6); PG8_BAR;
    } else {
        PG8_STAGE(PG8_SB(0, 0), cB, voffB); PG8_STAGE(PG8_SA(0, 0), cA, voffA); PG8_STAGE(PG8_SB(0, 1), cB + hstep, voffB); PG8_STAGE(PG8_SA(0, 1), cA + hstep, voffA);
        if (wr == 1) PG8_BAR;
        PG8_WAIT_V(4); PG8_BAR;
        PG8_STAGE(PG8_SB(1, 0), cB + kstep, voffB); PG8_STAGE(PG8_SA(1, 0), cA + kstep, voffA); PG8_STAGE(PG8_SB(1, 1), cB + hstep + kstep, voffB);
        PG8_WAIT_V(6); PG8_BAR;
    }
    for (;;) {
        const bool has_next = S.next(ui + 1, nxt);
        const char* nA = has_next ? (const char*)g.A + (size_t)nxt.pm * tstep : cA; const char* nB = has_next ? (const char*)g.Bt + (size_t)nxt.pn * tstep : cB;
        for (int t = 0; t < nt; t += 2) {
            const bool last = (t == nt - 2);
            const char* a1 = cA + (size_t)(t + 1) * kstep;
            const char* a2 = last ? nA : cA + (size_t)(t + 2) * kstep; const char* b2 = last ? nB : cB + (size_t)(t + 2) * kstep;
            const char* a3 = a2 + kstep; const char* b3 = b2 + kstep;
            if (last && has_next) S.a_ready(nxt);
            if constexpr (SP2) {
            PG8_LDB(B0, 0, 0); PG8_LDB(B1, 0, 1); PG8_SCHED; PG8_LDA(At, 0, 0); PG8_STAGE(PG8_SA(1, 1), a1 + hstep, voffA);
            PG8_WAIT_V(8); PG8_WAIT_L(0); PG8_BAR; PG8_MMA(0, 0, At, B0); PG8_MMA(0, 1, At, B1); PG8_BAR; PG8_SCHED;
            PG8_LDA(At, 0, 1); PG8_STAGE(PG8_SB(0, 0), b2, voffB); PG8_STAGE(PG8_SB(0, 1), b2 + hstep, voffB); PG8_STAGE(PG8_SA(0, 0), a2, voffA);
            PG8_WAIT_V(8); PG8_WAIT_L(0); PG8_BAR; PG8_MMA(1, 0, At, B0); PG8_MMA(1, 1, At, B1); PG8_BAR; PG8_SCHED;
            PG8_LDB(B0, 1, 0); PG8_LDB(B1, 1, 1); PG8_SCHED; PG8_LDA(At, 1, 0); PG8_STAGE(PG8_SA(0, 1), a2 + hstep, voffA);
            PG8_WAIT_V(8); PG8_WAIT_L(0); PG8_BAR; PG8_MMA(0, 0, At, B0); PG8_MMA(0, 1, At, B1); PG8_BAR; PG8_SCHED;
            PG8_LDA(At, 1, 1); PG8_STAGE(PG8_SB(1, 0), b3, voffB); PG8_STAGE(PG8_SB(1, 1), b3 + hstep, voffB); PG8_STAGE(PG8_SA(1, 0), a3, voffA);
            PG8_WAIT_V(8); PG8_WAIT_L(0); PG8_BAR; PG8_MMA(1, 0, At, B0); PG8_MMA(1, 1, At, B1); PG8_BAR; PG8_SCHED;
            } else {
            PG8_LDB(B0, 0, 0); PG8_SCHED; PG8_LDA(At, 0, 0); PG8_STAGE(PG8_SA(1, 1), a1 + hstep, voffA);
            PG8_WAIT_L(8); PG8_BAR; PG8_WAIT_L(0); PG8_MMA(0, 0, At, B0); PG8_BAR; PG8_SCHED;
            PG8_LDB(B1, 0, 1); PG8_STAGE(PG8_SB(0, 0), b2, voffB);
            PG8_BAR; PG8_WAIT_L(0); PG8_MMA(0, 1, At, B1); PG8_BAR;
            PG8_LDA(At, 0, 1); PG8_STAGE(PG8_SA(0, 0), a2, voffA);
            PG8_BAR; PG8_WAIT_L(0); PG8_MMA(1, 0, At, B0); PG8_BAR; PG8_SCHED;
            PG8_STAGE(PG8_SB(0, 1), b2 + hstep, voffB);
            PG8_WAIT_V(6); PG8_BAR; PG8_MMA(1, 1, At, B1); PG8_BAR;
            PG8_LDB(B0, 1, 0); PG8_SCHED; PG8_LDA(At, 1, 0); PG8_STAGE(PG8_SA(0, 1), a2 + hstep, voffA);
            PG8_WAIT_L(8); PG8_BAR; PG8_WAIT_L(0); PG8_MMA(0, 0, At, B0); PG8_BAR; PG8_SCHED;
            PG8_LDB(B1, 1, 1); PG8_STAGE(PG8_SB(1, 0), b3, voffB);
            PG8_BAR; PG8_WAIT_L(0); PG8_MMA(0, 1, At, B1); PG8_BAR;
            PG8_LDA(At, 1, 1); PG8_STAGE(PG8_SA(1, 0), a3, voffA);
            PG8_BAR; PG8_WAIT_L(0); PG8_MMA(1, 0, At, B0); PG8_BAR; PG8_SCHED;
            PG8_STAGE(PG8_SB(1, 1), b3 + hstep, voffB);
            PG8_WAIT_V(6); PG8_BAR; PG8_MMA(1, 1, At, B1); PG8_BAR;
            }
        }
        if constexpr (ALIGN_EPI) { if (wr == 0) PG8_BAR; }
        if constexpr (!Epi::AFTER_DRAIN) { E(acc, cur, wr, wc, fr, fq); S.done(cur); }
        if (!has_next) break;
#pragma unroll
        for (int a = 0; a < 2; ++a)
#pragma unroll
            for (int b = 0; b < 2; ++b)
#pragma unroll
                for (int m = 0; m < 4; ++m)
#pragma unroll
                    for (int n = 0; n < 2; ++n) acc[a][b][m][n] = (f32x4){0.f, 0.f, 0.f, 0.f};
        cur = nxt; cA = nA; cB = nB; ++ui;
        if constexpr (ALIGN_EPI) { if (wr == 1) PG8_BAR; }
    }
    PG8_WAIT_V(0);
    if constexpr (!ALIGN_EPI) { if (wr == 0) PG8_BAR; }
    PG8_BAR;
    if constexpr (Epi::AFTER_DRAIN) { E.fused(acc, cur, wr, wc, fr, fq, lds, wid, lane); S.done(cur); }
#undef PG8_SA
#undef PG8_SB
#undef PG8_STAGE
#undef PG8_LDA
#undef PG8_LDB
#undef PG8_MMA
#undef PG8_WAIT_V
#undef PG8_WAIT_L
#undef PG8_BAR
#undef PG8_SCHED
}
}

namespace pg8 {
typedef float f32x2 __attribute__((ext_vector_type(2)));
__device__ __forceinline__ void rows_rstd(const float* ss, int row0, float (&rs)[2][4]) {
    f32x4 p[2][4];
#pragma unroll
    for (int ai = 0; ai < 2; ++ai)
#pragma unroll
        for (int m = 0; m < 4; ++m) p[ai][m] = *(const f32x4*)(ss + (size_t)(row0 + ai * HALF + m * 16) * 4);
    asm volatile("" ::: "memory");
#pragma unroll
    for (int ai = 0; ai < 2; ++ai)
#pragma unroll
        for (int m = 0; m < 4; ++m) rs[ai][m] = __builtin_amdgcn_rsqf(((p[ai][m].x + p[ai][m].y) + (p[ai][m].z + p[ai][m].w)) * (1.f / 1024.f) + 1e-6f);
}

struct EpiSwiglu {
    static constexpr bool PERM = true, AFTER_DRAIN = false;
    bf16_t* H; const float* ss;
    __device__ __forceinline__ void operator()(const f32x4 (&acc)[2][2][4][2], const Unit& u, int wr, int wc, int fr, int fq) const {
        const int row0 = u.pm * BM + wr * 64 + fr, col0 = u.pn * 128 + wc * 32 + 8 * fq;
        float rsv[2][4]; rows_rstd(ss, row0, rsv);
#pragma unroll
        for (int ai = 0; ai < 2; ++ai)
#pragma unroll
            for (int m = 0; m < 4; ++m) {
                const int row = row0 + ai * HALF + m * 16; const float rs = rsv[ai][m], c1 = rs * -1.4426950408889634f, rs2 = rs * rs;
                u32x4 w;
#pragma unroll
                for (int q = 0; q < 4; ++q) {
                    const f32x4 G4 = acc[ai][0][m][q >> 1], U4 = acc[ai][1][m][q >> 1];
                    const f32x2 G = (q & 1) ? (f32x2){G4.z, G4.w} : (f32x2){G4.x, G4.y}, U = (q & 1) ? (f32x2){U4.z, U4.w} : (f32x2){U4.x, U4.y}, t = G * c1;
                    f32x2 e; e.x = __builtin_amdgcn_exp2f(t.x); e.y = __builtin_amdgcn_exp2f(t.y);
                    const f32x2 d = e + 1.f;
                    f32x2 r; r.x = __builtin_amdgcn_rcpf(d.x); r.y = __builtin_amdgcn_rcpf(d.y);
                    const f32x2 o = (G * U) * (r * rs2);
                    const unsigned pk = cvt_pk_bf16(o.x, o.y);
                    if (q == 0) w.x = pk; else if (q == 1) w.y = pk; else if (q == 2) w.z = pk; else w.w = pk; }
                *(u32x4*)(H + (size_t)row * 2816 + col0) = w; }
    }
};
struct EpiRes {
    static constexpr bool PERM = true, AFTER_DRAIN = false;
    bf16_t* XB; float* ss; float scale; PG8_LAS float* red;
    __device__ __forceinline__ void operator()(const f32x4 (&acc)[2][2][4][2], const Unit& u, int wr, int wc, int fr, int fq) const {
        const int row0 = u.pm * BM + wr * 64 + fr, col0 = u.pn * BM + wc * 32 + 8 * fq;
        u32x4 xv[2][4][2];
#pragma unroll
        for (int ai = 0; ai < 2; ++ai)
#pragma unroll
            for (int m = 0; m < 4; ++m)
#pragma unroll
                for (int bj = 0; bj < 2; ++bj) xv[ai][m][bj] = *(const u32x4*)(XB + (size_t)(row0 + ai * HALF + m * 16) * 1024 + col0 + bj * HALF);
        asm volatile("" ::: "memory");
#pragma unroll
        for (int ai = 0; ai < 2; ++ai)
#pragma unroll
            for (int m = 0; m < 4; ++m) {
                const int row = row0 + ai * HALF + m * 16; float sq = 0.f;
#pragma unroll
                for (int bj = 0; bj < 2; ++bj) {
                    const u32x4 o = xv[ai][m][bj];
                    const f32x4 p0 = (f32x4){__builtin_bit_cast(float, o.x << 16), __builtin_bit_cast(float, o.x & 0xffff0000u), __builtin_bit_cast(float, o.y << 16), __builtin_bit_cast(float, o.y & 0xffff0000u)};
                    const f32x4 p1 = (f32x4){__builtin_bit_cast(float, o.z << 16), __builtin_bit_cast(float, o.z & 0xffff0000u), __builtin_bit_cast(float, o.w << 16), __builtin_bit_cast(float, o.w & 0xffff0000u)};
                    const f32x4 x0 = p0 + acc[ai][bj][m][0] * scale, x1 = p1 + acc[ai][bj][m][1] * scale;
                    u32x4 w; w.x = cvt_pk_bf16(x0[0], x0[1]); w.y = cvt_pk_bf16(x0[2], x0[3]); w.z = cvt_pk_bf16(x1[0], x1[1]); w.w = cvt_pk_bf16(x1[2], x1[3]);
                    *(u32x4*)(XB + (size_t)row * 1024 + col0 + bj * HALF) = w;
                    sq += (x0[0] * x0[0] + x0[1] * x0[1]) + (x0[2] * x0[2] + x0[3] * x0[3]) + (x1[0] * x1[0] + x1[1] * x1[1]) + (x1[2] * x1[2] + x1[3] * x1[3]); }
                sq += __shfl_xor(sq, 16); sq += __shfl_xor(sq, 32);
                if (fq == 0) red[(wr * 64 + fr + ai * HALF + m * 16) * 4 + wc] = sq; }
        asm volatile("s_waitcnt lgkmcnt(0)" ::: "memory"); __builtin_amdgcn_s_barrier();
        { const int t = threadIdx.x; if (t < 256) { const f32x4 p = *(const PG8_LAS f32x4*)(red + t * 4); ss[(size_t)(u.pm * BM + t) * 4 + u.pn] = (p.x + p.y) + (p.z + p.w); } }
        asm volatile("s_waitcnt lgkmcnt(0)" ::: "memory"); __builtin_amdgcn_s_barrier();
    }
};
struct EpiProj {
    static constexpr bool PERM = true, AFTER_DRAIN = false;
    bf16_t* P; const float* ss;
    __device__ __forceinline__ void operator()(const f32x4 (&acc)[2][2][4][2], const Unit& u, int wr, int wc, int fr, int fq) const {
        const int row0 = u.pm * BM + wr * 64 + fr, col0 = u.pn * BM + wc * 32 + 8 * fq;
        float rsv[2][4]; rows_rstd(ss, row0, rsv);
#pragma unroll
        for (int ai = 0; ai < 2; ++ai)
#pragma unroll
            for (int m = 0; m < 4; ++m) {
                const int row = row0 + ai * HALF + m * 16; const float rs = rsv[ai][m];
#pragma unroll
                for (int bj = 0; bj < 2; ++bj) {
                    const f32x4 v0 = acc[ai][bj][m][0] * rs, v1 = acc[ai][bj][m][1] * rs;
                    u32x4 w; w.x = cvt_pk_bf16(v0[0], v0[1]); w.y = cvt_pk_bf16(v0[2], v0[3]); w.z = cvt_pk_bf16(v1[0], v1[1]); w.w = cvt_pk_bf16(v1[2], v1[3]);
                    *(u32x4*)(P + (size_t)row * 1792 + col0 + bj * HALF) = w; } }
    }
};
}

#define LAS __attribute__((address_space(3)))
typedef unsigned short bf16;
typedef short bf16x8 __attribute__((ext_vector_type(8)));
typedef float f32x4 __attribute__((ext_vector_type(4)));
typedef float f32x2 __attribute__((ext_vector_type(2)));
typedef float f32x16 __attribute__((ext_vector_type(16)));
typedef unsigned u32x4 __attribute__((ext_vector_type(4)));
typedef unsigned u32x2 __attribute__((ext_vector_type(2)));
#define MFMA32(a, b, c) __builtin_amdgcn_mfma_f32_32x32x16_bf16((a), (b), (c), 0, 0, 0)

constexpr int NB = 4, SEQ = 4096, T = NB * SEQ, D = 1024, FF = 2816, NGU = 2 * FF, DIN = 1792, DEPTH = 4, LW = 512;
constexpr int NCH = SEQ / 32;
constexpr int NWAVES = 8, NTHR = 512;
constexpr int LDS_BTAB = 131072 + 256 + 4096, LDS_RSTD = LDS_BTAB + 8 * 384 * 4, LDS_BYTES = LDS_RSTD + 2048;
constexpr size_t W_GU1 = 0, W_D1 = W_GU1 + (size_t)NGU * D, W_IN = W_D1 + (size_t)D * FF, W_OUT = W_IN + (size_t)DIN * D, W_GU2 = W_OUT + (size_t)D * D,
                 W_D2 = W_GU2 + (size_t)NGU * D, W_LRU = W_D2 + (size_t)D * FF, W_LAYER = W_LRU + 131072;
constexpr size_t MiB = 1u << 20;
constexpr size_t WS_W = 1 * MiB, WS_XB = 160 * MiB, WS_H = 192 * MiB, WS_PROJ = WS_H, WS_Y = WS_H + 56 * MiB, WS_SS = 280 * MiB, WS_TOT = 281 * MiB, WS_CAR = 285 * MiB, WS_HP = 287 * MiB, WS_END = 351 * MiB;
static_assert(WS_W + W_LAYER * 2 * DEPTH <= WS_XB && (size_t)T * FF * 2 <= 88 * MiB && (size_t)T * DIN * 2 <= 56 * MiB, "ws map");

struct Args { const float* in[24]; float* out; unsigned char* ws; int coop; int pad; };


__device__ __forceinline__ unsigned f2bf(float f) { unsigned u = __builtin_bit_cast(unsigned, f); return (u + 0x7fffu + ((u >> 16) & 1u)) >> 16; }
__device__ __forceinline__ unsigned pk2(float lo, float hi) { return f2bf(lo) | (f2bf(hi) << 16); }
__device__ __forceinline__ float bf2f(unsigned short b) { return __builtin_bit_cast(float, (unsigned)b << 16); }
__device__ __forceinline__ float wave_sum(float v) {
#pragma unroll
    for (int o = 1; o < 64; o <<= 1) v += __shfl_xor(v, o);
    return v;
}
#define LDS_WAVE_SYNC() asm volatile("s_waitcnt lgkmcnt(0)" ::: "memory")
__device__ __forceinline__ float sigmoid_f(float x) { return __builtin_amdgcn_rcpf(1.f + __expf(-x)); }
__device__ __forceinline__ float gelu_tanh(float x) {
    const float z = 0.7978845608028654f * (x + 0.044715f * x * x * x);
    const float e = __expf(2.f * z);
    const float th = 1.f - 2.f * __builtin_amdgcn_rcpf(e + 1.f);
    return 0.5f * x * (1.f + th);
}

template <bool HASG>
__device__ __forceinline__ void tr_item(const float* W, int K, int N, bf16* WT, int rowmode, const float* g, LAS float* scr, int item, int lane) {
    const int nblk = N / 32, kb = item / nblk, nb = item % nblk, k0 = 64 * kb, n0 = 32 * nb;
    const float* wp = W + (size_t)(k0 + (lane >> 5)) * N + n0 + (lane & 31);
    const int c = lane & 7;
    float v[32];
#pragma unroll
    for (int i = 0; i < 32; ++i) v[i] = wp[(size_t)(2 * i) * N];
    f32x4 g0 = (f32x4){1.f, 1.f, 1.f, 1.f}, g1 = g0;
    if (HASG) { g0 = *(const f32x4*)(g + k0 + 8 * c); g1 = *(const f32x4*)(g + k0 + 8 * c + 4); }
    asm volatile("" ::: "memory");
#pragma unroll
    for (int i = 0; i < 32; ++i) scr[(2 * i + (lane >> 5)) * 33 + (lane & 31)] = v[i];
    LDS_WAVE_SYNC();
    const int drow0 = rowmode == 0 ? n0 : ((n0 >> 7) * 256 + (n0 & 127) + (rowmode == 2 ? 128 : 0));
#pragma unroll
    for (int j = 0; j < 4; ++j) { const int n = (lane >> 3) + 8 * j; const LAS float* s = scr + (8 * c) * 33 + n;
        u32x4 o; o.x = pk2(s[0 * 33] * g0.x, s[1 * 33] * g0.y); o.y = pk2(s[2 * 33] * g0.z, s[3 * 33] * g0.w);
        o.z = pk2(s[4 * 33] * g1.x, s[5 * 33] * g1.y); o.w = pk2(s[6 * 33] * g1.z, s[7 * 33] * g1.w);
        *(u32x4*)(WT + (size_t)(drow0 + n) * K + k0 + 8 * c) = o; }
    LDS_WAVE_SYNC();
}

constexpr int I_G = 16 * 88, I_D = 44 * 32, I_IN = 16 * 56, I_OUT = 16 * 32, I_L = 64;
constexpr int PER = 2 * (2 * I_G + I_D) + I_IN + I_OUT + I_L;
__device__ __forceinline__ void convert_items(const Args& a, LAS unsigned char* lds, int l, int it_lo, int it_hi, int gw, int NGW, int wave, int lane) {
    LAS float* scr = (LAS float*)(lds + wave * 8704);
    bf16* WB = (bf16*)(a.ws + WS_W);
#pragma unroll 1
    for (int it = it_lo + gw; it < it_hi; it += NGW) {
        int r = it; bf16* wl = WB + (size_t)l * W_LAYER;
        const size_t o_gu = (size_t)l * D * FF, o_d = (size_t)l * FF * D;
        if (r < I_G) { tr_item<true>(a.in[2] + o_gu, D, FF, wl + W_GU1, 1, a.in[1] + l * D, scr, r, lane); continue; } r -= I_G;
        if (r < I_G) { tr_item<true>(a.in[3] + o_gu, D, FF, wl + W_GU1, 2, a.in[1] + l * D, scr, r, lane); continue; } r -= I_G;
        if (r < I_D) { tr_item<false>(a.in[4] + o_d, FF, D, wl + W_D1, 0, nullptr, scr, r, lane); continue; } r -= I_D;
        if (r < I_IN) { tr_item<true>(a.in[6] + (size_t)l * D * DIN, D, DIN, wl + W_IN, 0, a.in[5] + l * D, scr, r, lane); continue; } r -= I_IN;
        if (r < I_OUT) { tr_item<false>(a.in[18] + (size_t)l * D * D, D, D, wl + W_OUT, 0, nullptr, scr, r, lane); continue; } r -= I_OUT;
        if (r < I_G) { tr_item<true>(a.in[20] + o_gu, D, FF, wl + W_GU2, 1, a.in[19] + l * D, scr, r, lane); continue; } r -= I_G;
        if (r < I_G) { tr_item<true>(a.in[21] + o_gu, D, FF, wl + W_GU2, 2, a.in[19] + l * D, scr, r, lane); continue; } r -= I_G;
        if (r < I_D) { tr_item<false>(a.in[22] + o_d, FF, D, wl + W_D2, 0, nullptr, scr, r, lane); continue; } r -= I_D;
        { const int mat = r >> 1, nbk = r & 1, gate = mat & 1, blk = (mat >> 1) & 7, d = mat >> 4;
          const float* src = (gate ? a.in[11] : a.in[9]) + (size_t)((l * 2 + d) * 8 + blk) * 4096;
          tr_item<false>(src, 64, 64, wl + W_LRU + (size_t)((d * 8 + blk) * 2 + gate) * 4096, 0, nullptr, scr, nbk, lane); }
    }
}
__device__ __forceinline__ void x_prologue(const Args& a, int gw, int NGW, int lane) {
    bf16* XB = (bf16*)(a.ws + WS_XB); float* SS = (float*)(a.ws + WS_SS);
#pragma unroll 1
    for (int m0 = gw; m0 < T; m0 += 4 * NGW) {
        f32x4 v[4][4];
#pragma unroll
        for (int q = 0; q < 4; ++q) { const int m = m0 + q * NGW, mc = m < T ? m : gw; const f32x4* xr = (const f32x4*)(a.in[0] + (size_t)mc * D) + lane;
#pragma unroll
            for (int j = 0; j < 4; ++j) v[q][j] = xr[64 * j]; }
        asm volatile("" ::: "memory");
#pragma unroll
        for (int q = 0; q < 4; ++q) { const int m = m0 + q * NGW; if (m < T) {
            u32x2* xb = (u32x2*)(XB + (size_t)m * D) + lane; float s = 0.f;
#pragma unroll
            for (int j = 0; j < 4; ++j) { const f32x4 w = v[q][j]; s += (w.x * w.x + w.y * w.y) + (w.z * w.z + w.w * w.w);
                u32x2 o; o.x = pk2(w.x, w.y); o.y = pk2(w.z, w.w); xb[64 * j] = o; }
            s = wave_sum(s);
            if (lane < 4) SS[(size_t)m * 4 + lane] = lane == 0 ? s : 0.f; } }
    }
}

template <int DIR, int MODE>
__device__ __forceinline__ void lru_dir(const Args& a, int l, int b, int ch, int w, int lane, const bf16x8 (&af)[4], const float (&xcr)[32], float (&hf)[32],
                                        LAS float* au, const bf16* wl, const float (&gl)[32], const float (&prm)[2][2][3]) {
    const int r32 = lane & 31, h = lane >> 5, c = w * 64 + lane;
    f32x16 accR[2], accI[2];
#pragma unroll
    for (int nt = 0; nt < 2; ++nt) {
#pragma unroll
        for (int i = 0; i < 16; ++i) { accR[nt][i] = 0.f; accI[nt][i] = 0.f; }
        const bf16* wr_ = wl + (size_t)((DIR * 8 + w) * 2) * 4096 + (nt * 32 + r32) * 64 + 8 * h;
#pragma unroll
        for (int ks = 0; ks < 4; ++ks) {
            const bf16x8 bR = *(const bf16x8*)(wr_ + 16 * ks), bI = *(const bf16x8*)(wr_ + 4096 + 16 * ks);
            accR[nt] = MFMA32(af[ks], bR, accR[nt]); accI[nt] = MFMA32(af[ks], bI, accI[nt]); }
    }
#pragma unroll
    for (int nt = 0; nt < 2; ++nt) {
        const float nba = prm[DIR][nt][0], nbx = prm[DIR][nt][1], k8l = prm[DIR][nt][2];
#pragma unroll
        for (int i = 0; i < 16; ++i) {
            const float d1 = 1.f + __builtin_amdgcn_exp2f(__builtin_fmaf(accR[nt][i], -1.4426950408889634f, nba));
            const float d2 = 1.f + __builtin_amdgcn_exp2f(__builtin_fmaf(accI[nt][i], -1.4426950408889634f, nbx));
            const float inv = __builtin_amdgcn_rcpf(d1 * d2), rr = inv * d2, ii = inv * d1;
            const float av = __builtin_amdgcn_exp2f(k8l * rr);
            accR[nt][i] = av; accI[nt][i] = __builtin_amdgcn_sqrtf(fmaxf(__builtin_fmaf(-av, av, 1.f), 0.f)) * ii; }
    }
    float hc = 0.f, ap = 1.f;
    if (MODE == 1) hc = ((const float*)(a.ws + WS_CAR))[(size_t)((b * NCH + ch) * 2 + DIR) * LW + c];
#pragma unroll
    for (int hh = 0; hh < 2; ++hh) {
        const int half = DIR == 0 ? hh : 1 - hh;
#pragma unroll
        for (int nt = 0; nt < 2; ++nt)
#pragma unroll
            for (int i = 0; i < 8; ++i) { const int tt = 8 * (i >> 2) + 4 * h + (i & 3);
                f32x2 v; v.x = accR[nt][8 * half + i]; v.y = accI[nt][8 * half + i];
                *(LAS f32x2*)(au + (tt * 64 + nt * 32 + r32) * 2) = v; }
        LDS_WAVE_SYNC();
#pragma unroll
        for (int s = 0; s < 16; ++s) {
            const int tt = DIR == 0 ? s : 15 - s, t = half * 16 + tt;
            const f32x2 v = *(const LAS f32x2*)(au + (tt * 64 + lane) * 2);
            hc = v.x * hc + v.y * xcr[t];
            if (MODE == 0) { ap *= v.x;
                ((unsigned*)(a.ws + WS_HP))[((size_t)DIR * T + (size_t)b * SEQ + ch * 32 + t) * LW + c] = pg8::cvt_pk_bf16(hc, ap); }
            if (MODE == 1) { if (DIR == 0) hf[t] = hc; else hf[t] = gl[t] * (hf[t] + hc); }
        }
        LDS_WAVE_SYNC();
    }
    if (MODE == 0) { f32x2 v; v.x = ap; v.y = hc; ((f32x2*)(a.ws + WS_TOT))[(size_t)((b * NCH + ch) * 2 + DIR) * LW + c] = v; }
}


__device__ __forceinline__ void carry_phase(const Args& a, int bx) {
    int tid_ = threadIdx.x; asm volatile("" : "+v"(tid_));
    const int gt = bx * NTHR + tid_;
    if (gt >= NB * 2 * LW) return;
    const int b = gt >> 10, dir = (gt >> 9) & 1, c = gt & 511;
    const f32x2* tot = (const f32x2*)(a.ws + WS_TOT); float* car = (float*)(a.ws + WS_CAR);
    float hc = 0.f;
#pragma unroll 1
    for (int j0 = 0; j0 < NCH; j0 += 32) {
        f32x2 v[32];
#pragma unroll
        for (int i = 0; i < 32; ++i) { const int j = j0 + i, cj = dir == 0 ? j : NCH - 1 - j; v[i] = tot[(size_t)((b * NCH + cj) * 2 + dir) * LW + c]; }
#pragma unroll
        for (int i = 0; i < 32; ++i) { const int j = j0 + i, cj = dir == 0 ? j : NCH - 1 - j; car[(size_t)((b * NCH + cj) * 2 + dir) * LW + c] = hc; hc = v[i].x * hc + v[i].y; }
    }
}

template <int MODE>
__device__ __forceinline__ void lru_unit(const Args& a, int l, int b, int ch, LAS unsigned char* lds) {
    int tid_ = threadIdx.x; asm volatile("" : "+v"(tid_));
    const int tid = tid_, w = __builtin_amdgcn_readfirstlane(tid >> 6), lane = tid & 63, r32 = lane & 31, h = lane >> 5;
    const int c = w * 64 + lane, t0 = ch * 32;
    const bf16* proj = (const bf16*)(a.ws + WS_PROJ);
    LAS unsigned char* xcb = lds + w * 12800;
    LAS float* au = (LAS float*)(lds + w * 12800 + 4608);
    const float* cw = a.in[7] + (size_t)l * 4 * LW;
    const float cw0 = cw[c], cw1 = cw[LW + c], cw2 = cw[2 * LW + c], cw3 = cw[3 * LW + c], cb = a.in[8][l * LW + c];
    float prm[2][2][3];
#pragma unroll
    for (int d = 0; d < 2; ++d)
#pragma unroll
        for (int nt = 0; nt < 2; ++nt) { const int cc = (l * 2 + d) * LW + w * 64 + nt * 32 + r32;
            prm[d][nt][0] = a.in[10][cc]; prm[d][nt][1] = a.in[12][cc]; prm[d][nt][2] = a.in[13][cc]; }
    const bf16* xp = proj + (size_t)b * SEQ * DIN + c;
    float xin[35], gl[32];
    unsigned short xraw[35], graw[32];
#pragma unroll
    for (int i = 0; i < 35; ++i) { const int t = t0 - 2 + i, tc = t < 0 ? 0 : (t >= SEQ ? SEQ - 1 : t); xraw[i] = xp[(size_t)tc * DIN]; }
    if (MODE == 1) {
#pragma unroll
        for (int t = 0; t < 32; ++t) graw[t] = xp[(size_t)(t0 + t) * DIN + LW];
    }
    asm volatile("" ::: "memory");
#pragma unroll
    for (int i = 0; i < 35; ++i) { const int t = t0 - 2 + i; xin[i] = (t >= 0 && t < SEQ) ? bf2f(xraw[i]) : 0.f; }
    if (MODE == 1) {
#pragma unroll
        for (int t = 0; t < 32; ++t) gl[t] = gelu_tanh(bf2f(graw[t]));
    }
    float xcr[32], hf[32];
#pragma unroll
    for (int t = 0; t < 32; ++t) { const float xc = cw0 * xin[t] + cw1 * xin[t + 1] + cw2 * xin[t + 2] + cw3 * xin[t + 3] + cb; xcr[t] = xc; hf[t] = 0.f;
        *(LAS bf16*)(xcb + t * 144 + lane * 2) = (bf16)f2bf(xc); }
#pragma unroll
    for (int d = 0; d < 2; ++d)
#pragma unroll
        for (int nt = 0; nt < 2; ++nt) { prm[d][nt][0] *= -1.4426950408889634f; prm[d][nt][1] *= -1.4426950408889634f;
            prm[d][nt][2] = -8.f * 1.4426950408889634f * log1pf(__expf(-prm[d][nt][2])); }
    LDS_WAVE_SYNC();
    bf16x8 af[4];
#pragma unroll
    for (int ks = 0; ks < 4; ++ks) af[ks] = *(const LAS bf16x8*)(xcb + r32 * 144 + (16 * ks + 8 * h) * 2);
    const bf16* wl = (const bf16*)(a.ws + WS_W) + (size_t)l * W_LAYER + W_LRU;
    lru_dir<0, MODE>(a, l, b, ch, w, lane, af, xcr, hf, au, wl, gl, prm);
    lru_dir<1, MODE>(a, l, b, ch, w, lane, af, xcr, hf, au, wl, gl, prm);
    if (MODE == 1) {
        __syncthreads();
        LAS float* yp = (LAS float*)lds;
#pragma unroll
        for (int t = 0; t < 32; ++t) yp[t * LW + c] = hf[t];
        __syncthreads();
        const float* gn = a.in[16] + l * LW + lane * 8;
        const f32x4 g0 = *(const f32x4*)gn, g1 = *(const f32x4*)(gn + 4);
        bf16* Y = (bf16*)(a.ws + WS_Y);
#pragma unroll
        for (int i = 0; i < 4; ++i) { const int t = w * 4 + i;
            const f32x4 v0 = *(const LAS f32x4*)(yp + t * LW + lane * 8), v1 = *(const LAS f32x4*)(yp + t * LW + lane * 8 + 4);
            float s = (v0.x * v0.x + v0.y * v0.y) + (v0.z * v0.z + v0.w * v0.w) + (v1.x * v1.x + v1.y * v1.y) + (v1.z * v1.z + v1.w * v1.w);
            s = wave_sum(s); const float rs = __builtin_amdgcn_rsqf(s * (1.f / 512.f) + 1e-6f);
            u32x4 o; o.x = pk2(v0.x * rs * g0.x, v0.y * rs * g0.y); o.y = pk2(v0.z * rs * g0.z, v0.w * rs * g0.w);
            o.z = pk2(v1.x * rs * g1.x, v1.y * rs * g1.y); o.w = pk2(v1.z * rs * g1.z, v1.w * rs * g1.w);
            *(u32x4*)(Y + ((size_t)b * SEQ + t0 + t) * D + lane * 8) = o; }
    }
}


__device__ __forceinline__ void lru_finish(const Args& a, int l, int gw, int NGW, int lane) {
    const bf16* proj = (const bf16*)(a.ws + WS_PROJ); const unsigned* HP = (const unsigned*)(a.ws + WS_HP); const float* CAR = (const float*)(a.ws + WS_CAR);
    bf16* Y = (bf16*)(a.ws + WS_Y);
    const float* gn = a.in[16] + l * LW + lane * 8;
    const f32x4 gn0 = *(const f32x4*)gn, gn1 = *(const f32x4*)(gn + 4);
#pragma unroll 1
    for (int row = gw; row < T; row += NGW) {
        const int b = row >> 12, ch = (row & (SEQ - 1)) >> 5;
        const unsigned* hpf = HP + (size_t)row * LW + lane * 8; const unsigned* hpb = hpf + (size_t)T * LW;
        const float* cf = CAR + (size_t)((b * NCH + ch) * 2) * LW + lane * 8; const float* cb = cf + LW;
        const u32x4 f0 = *(const u32x4*)hpf, f1 = *(const u32x4*)(hpf + 4), b0 = *(const u32x4*)hpb, b1 = *(const u32x4*)(hpb + 4);
        const u32x4 gq = *(const u32x4*)(proj + (size_t)row * DIN + LW + lane * 8);
        const f32x4 cf0 = *(const f32x4*)cf, cf1 = *(const f32x4*)(cf + 4), cb0 = *(const f32x4*)cb, cb1 = *(const f32x4*)(cb + 4);
        asm volatile("" ::: "memory");
        float y[8]; float s = 0.f;
#pragma unroll
        for (int i = 0; i < 8; ++i) {
            const unsigned fw = i < 4 ? f0[i & 3] : f1[i & 3], bw = i < 4 ? b0[i & 3] : b1[i & 3], gw2 = gq[i >> 1];
            const float cfi = i < 4 ? cf0[i & 3] : cf1[i & 3], cbi = i < 4 ? cb0[i & 3] : cb1[i & 3];
            const float hlf = __builtin_bit_cast(float, fw << 16), pf_ = __builtin_bit_cast(float, fw & 0xffff0000u);
            const float hlb = __builtin_bit_cast(float, bw << 16), pb_ = __builtin_bit_cast(float, bw & 0xffff0000u);
            const float g = __builtin_bit_cast(float, (i & 1) ? (gw2 & 0xffff0000u) : (gw2 << 16));
            y[i] = gelu_tanh(g) * ((hlf + pf_ * cfi) + (hlb + pb_ * cbi)); s += y[i] * y[i]; }
        s = wave_sum(s); const float rs = __builtin_amdgcn_rsqf(s * (1.f / 512.f) + 1e-6f);
        u32x4 o; o.x = pk2(y[0] * rs * gn0.x, y[1] * rs * gn0.y); o.y = pk2(y[2] * rs * gn0.z, y[3] * rs * gn0.w);
        o.z = pk2(y[4] * rs * gn1.x, y[5] * rs * gn1.y); o.w = pk2(y[6] * rs * gn1.z, y[7] * rs * gn1.w);
        *(u32x4*)(Y + (size_t)row * D + lane * 8) = o;
    }
}


__device__ __forceinline__ void lru_finish2(const Args& a, int l, int bx, int G, LAS unsigned char* lds) {
    int tid_ = threadIdx.x; asm volatile("" : "+v"(tid_));
    const int tid = tid_, lane = tid & 63, wave = __builtin_amdgcn_readfirstlane(tid >> 6);
    const bf16* proj = (const bf16*)(a.ws + WS_PROJ); const unsigned* HP = (const unsigned*)(a.ws + WS_HP); const f32x2* tot = (const f32x2*)(a.ws + WS_TOT);
    bf16* Y = (bf16*)(a.ws + WS_Y);
    LAS float* car = (LAS float*)lds;
    const float* gn = a.in[16] + l * LW + lane * 8;
    const f32x4 gn0 = *(const f32x4*)gn, gn1 = *(const f32x4*)(gn + 4);
#pragma unroll 1
    for (int p = bx; p < NB * NCH / 2; p += G) {
        const int b = p / (NCH / 2), ch0 = 2 * (p % (NCH / 2)), ch1 = ch0 + 1;
        __syncthreads();
        { const int c = tid, nf = ch0, nb = NCH - 1 - ch1, nmax = nf > nb ? nf : nb;
          float hf = 0.f, hb = 0.f;
#pragma unroll 1
          for (int j0 = 0; j0 < nmax; j0 += 32) {
              f32x2 vf[32], vb[32];
#pragma unroll
              for (int i = 0; i < 32; ++i) { const int j = j0 + i, jf = j < nf ? j : 0, jb = j < nb ? NCH - 1 - j : NCH - 1;
                  vf[i] = tot[(size_t)((b * NCH + jf) * 2 + 0) * LW + c]; vb[i] = tot[(size_t)((b * NCH + jb) * 2 + 1) * LW + c]; }
              asm volatile("" ::: "memory");
#pragma unroll
              for (int i = 0; i < 32; ++i) { const int j = j0 + i;
                  if (j < nf) hf = vf[i].x * hf + vf[i].y;
                  if (j < nb) hb = vb[i].x * hb + vb[i].y; }
          }
          const f32x2 t0 = tot[(size_t)((b * NCH + ch0) * 2 + 0) * LW + c], t1 = tot[(size_t)((b * NCH + ch1) * 2 + 1) * LW + c];
          car[c] = hf; car[LW + c] = t0.x * hf + t0.y; car[3 * LW + c] = hb; car[2 * LW + c] = t1.x * hb + t1.y; }
        __syncthreads();
#pragma unroll 1
        for (int it = 0; it < 2; ++it) {
            u32x4 f0[4], f1[4], b0[4], b1[4], gq[4];
#pragma unroll
            for (int q = 0; q < 4; ++q) { const int rl = wave * 8 + it * 4 + q; const size_t row = (size_t)b * SEQ + ch0 * 32 + rl;
                const unsigned* hpf = HP + row * LW + lane * 8; const unsigned* hpb = hpf + (size_t)T * LW;
                f0[q] = *(const u32x4*)hpf; f1[q] = *(const u32x4*)(hpf + 4); b0[q] = *(const u32x4*)hpb; b1[q] = *(const u32x4*)(hpb + 4);
                gq[q] = *(const u32x4*)(proj + row * DIN + LW + lane * 8); }
            asm volatile("" ::: "memory");
#pragma unroll
            for (int q = 0; q < 4; ++q) { const int rl = wave * 8 + it * 4 + q, k = rl >> 5; const size_t row = (size_t)b * SEQ + ch0 * 32 + rl;
                const f32x4 cf0 = *(const LAS f32x4*)(car + k * LW + lane * 8), cf1 = *(const LAS f32x4*)(car + k * LW + lane * 8 + 4);
                const f32x4 cb0 = *(const LAS f32x4*)(car + (2 + k) * LW + lane * 8), cb1 = *(const LAS f32x4*)(car + (2 + k) * LW + lane * 8 + 4);
                float y[8]; float s = 0.f;
#pragma unroll
                for (int i = 0; i < 8; ++i) {
                    const unsigned fw = i < 4 ? f0[q][i & 3] : f1[q][i & 3], bw = i < 4 ? b0[q][i & 3] : b1[q][i & 3], gw2 = gq[q][i >> 1];
                    const float cfi = i < 4 ? cf0[i & 3] : cf1[i & 3], cbi = i < 4 ? cb0[i & 3] : cb1[i & 3];
                    const float hlf = __builtin_bit_cast(float, fw << 16), pf_ = __builtin_bit_cast(float, fw & 0xffff0000u);
                    const float hlb = __builtin_bit_cast(float, bw << 16), pb_ = __builtin_bit_cast(float, bw & 0xffff0000u);
                    const float g = __builtin_bit_cast(float, (i & 1) ? (gw2 & 0xffff0000u) : (gw2 << 16));
                    y[i] = gelu_tanh(g) * ((hlf + pf_ * cfi) + (hlb + pb_ * cbi)); s += y[i] * y[i]; }
                s = wave_sum(s); const float rs = __builtin_amdgcn_rsqf(s * (1.f / 512.f) + 1e-6f);
                u32x4 o; o.x = pk2(y[0] * rs * gn0.x, y[1] * rs * gn0.y); o.y = pk2(y[2] * rs * gn0.z, y[3] * rs * gn0.w);
                o.z = pk2(y[4] * rs * gn1.x, y[5] * rs * gn1.y); o.w = pk2(y[6] * rs * gn1.z, y[7] * rs * gn1.w);
                *(u32x4*)(Y + row * D + lane * 8) = o; }
        }
    }
}

__device__ __forceinline__ void lru_finish3(const Args& a, int l, int bx, int G, LAS unsigned char* lds) {
    int tid_ = threadIdx.x; asm volatile("" : "+v"(tid_));
    const int tid = tid_, lane = tid & 63, wave = __builtin_amdgcn_readfirstlane(tid >> 6);
    const bf16* proj = (const bf16*)(a.ws + WS_PROJ); const unsigned* HP = (const unsigned*)(a.ws + WS_HP);
    bf16* Y = (bf16*)(a.ws + WS_Y);
    const float* gn = a.in[16] + l * LW + lane * 8;
    const f32x4 gn0 = *(const f32x4*)gn, gn1 = *(const f32x4*)(gn + 4);
#pragma unroll 1
    for (int p = bx; p < NB * NCH / 2; p += G) {
        const int b = p / (NCH / 2), ch0 = 2 * (p % (NCH / 2)), ch1 = ch0 + 1;
        const int kw = wave >> 2;
        const float* cfp = (const float*)(a.ws + WS_CAR) + (size_t)((b * NCH + ch0 + kw) * 2) * LW + lane * 8;
        const f32x4 cf0 = *(const f32x4*)cfp, cf1 = *(const f32x4*)(cfp + 4), cb0 = *(const f32x4*)(cfp + LW), cb1 = *(const f32x4*)(cfp + LW + 4);
#pragma unroll 1
        for (int it = 0; it < 2; ++it) {
            u32x4 f0[4], f1[4], b0[4], b1[4], gq[4];
#pragma unroll
            for (int q = 0; q < 4; ++q) { const int rl = wave * 8 + it * 4 + q; const size_t row = (size_t)b * SEQ + ch0 * 32 + rl;
                const unsigned* hpf = HP + row * LW + lane * 8; const unsigned* hpb = hpf + (size_t)T * LW;
                f0[q] = *(const u32x4*)hpf; f1[q] = *(const u32x4*)(hpf + 4); b0[q] = *(const u32x4*)hpb; b1[q] = *(const u32x4*)(hpb + 4);
                gq[q] = *(const u32x4*)(proj + row * DIN + LW + lane * 8); }
            asm volatile("" ::: "memory");
#pragma unroll
            for (int q = 0; q < 4; ++q) { const int rl = wave * 8 + it * 4 + q; const size_t row = (size_t)b * SEQ + ch0 * 32 + rl;
                float y[8]; float s = 0.f;
#pragma unroll
                for (int i = 0; i < 8; ++i) {
                    const unsigned fw = i < 4 ? f0[q][i & 3] : f1[q][i & 3], bw = i < 4 ? b0[q][i & 3] : b1[q][i & 3], gw2 = gq[q][i >> 1];
                    const float cfi = i < 4 ? cf0[i & 3] : cf1[i & 3], cbi = i < 4 ? cb0[i & 3] : cb1[i & 3];
                    const float hlf = __builtin_bit_cast(float, fw << 16), pf_ = __builtin_bit_cast(float, fw & 0xffff0000u);
                    const float hlb = __builtin_bit_cast(float, bw << 16), pb_ = __builtin_bit_cast(float, bw & 0xffff0000u);
                    const float g = __builtin_bit_cast(float, (i & 1) ? (gw2 & 0xffff0000u) : (gw2 << 16));
                    y[i] = gelu_tanh(g) * ((hlf + pf_ * cfi) + (hlb + pb_ * cbi)); s += y[i] * y[i]; }
                s = wave_sum(s); const float rs = __builtin_amdgcn_rsqf(s * (1.f / 512.f) + 1e-6f);
                u32x4 o; o.x = pk2(y[0] * rs * gn0.x, y[1] * rs * gn0.y); o.y = pk2(y[2] * rs * gn0.z, y[3] * rs * gn0.w);
                o.z = pk2(y[4] * rs * gn1.x, y[5] * rs * gn1.y); o.w = pk2(y[6] * rs * gn1.z, y[7] * rs * gn1.w);
                *(u32x4*)(Y + row * D + lane * 8) = o; }
        }
    }
}

constexpr int AT_BIAS = 0, AT_RED = 8448, AT_K = 9472, KPITCH = 72, AT_V = AT_K + 320 * KPITCH * 2;
typedef short v4i16_t __attribute__((ext_vector_type(4)));
__device__ __forceinline__ bf16x8 vtr8(const LAS unsigned char* p) {
    const v4i16_t lo = __builtin_amdgcn_ds_read_tr16_b64_v4i16((LAS v4i16_t*)p), hi = __builtin_amdgcn_ds_read_tr16_b64_v4i16((LAS v4i16_t*)(p + 8 * KPITCH * 2));
    return __builtin_shufflevector(lo, hi, 0, 1, 2, 3, 4, 5, 6, 7);
}
__device__ __forceinline__ void attn_unit(const Args& a, int l, int b, int qb, LAS unsigned char* lds) {
    int tid_ = threadIdx.x; asm volatile("" : "+v"(tid_));
    const int tid = tid_, w = __builtin_amdgcn_readfirstlane(tid >> 6), lane = tid & 63, r32 = lane & 31, h = lane >> 5;
    const bf16* proj = (const bf16*)(a.ws + WS_PROJ);
    const LAS float* btab = (const LAS float*)(lds + LDS_BTAB); LAS float* red = (LAS float*)(lds + AT_RED); LAS bf16* Kl = (LAS bf16*)(lds + AT_K); LAS bf16* Vl = (LAS bf16*)(lds + AT_V);
    const size_t rowb = (size_t)b * SEQ; const int q0 = qb * 64, kw0 = q0 - 128;
    const int mt = w & 1, hq = w >> 1, qpos = q0 + mt * 32 + r32;
    const int trofs = (4 * h + ((lane & 15) >> 2)) * (KPITCH * 2) + 32 * ((lane >> 4) & 1) + 8 * (lane & 3);
    f32x16 O[2][2];
#pragma unroll
    for (int kvh = 0; kvh < 2; ++kvh) {
        const int head = kvh * 4 + hq;
        __syncthreads();
        bf16x8 qf[4];
        const float sink_raw = a.in[14][l * 8 + head];
        { u32x4 kq[5], vq[5];
#pragma unroll
          for (int q = 0; q < 5; ++q) { const int it = tid + q * NTHR, key = it >> 3, dc = it & 7, kp = kw0 + key, kc = kp < 0 ? 0 : (kp >= SEQ ? SEQ - 1 : kp);
              const bf16* src = proj + (rowb + kc) * DIN + 1536 + kvh * 64 + dc * 8; kq[q] = *(const u32x4*)src; vq[q] = *(const u32x4*)(src + 128); }
#pragma unroll
          for (int ks = 0; ks < 4; ++ks) qf[ks] = *(const bf16x8*)(proj + (rowb + qpos) * DIN + 1024 + head * 64 + 16 * ks + 8 * h);
          asm volatile("" ::: "memory");
#pragma unroll
          for (int q = 0; q < 5; ++q) { const int it = tid + q * NTHR, key = it >> 3, dc = it & 7, kp = kw0 + key; const bool in = kp >= 0 && kp < SEQ;
              const u32x4 z = (u32x4){0u, 0u, 0u, 0u};
              *(LAS u32x4*)(Kl + key * KPITCH + dc * 8) = in ? kq[q] : z; *(LAS u32x4*)(Vl + key * KPITCH + dc * 8) = in ? vq[q] : z; } }
        __syncthreads();
        const float sink = sink_raw * 1.4426950408889634f;
        float m = sink, lsum = 1.f;
#pragma unroll
        for (int dt = 0; dt < 2; ++dt)
#pragma unroll
            for (int i = 0; i < 16; ++i) O[kvh][dt][i] = 0.f;
        const LAS float* bT = btab + head * 384 + 192 + 4 * h - qpos;
#pragma unroll 1
        for (int jp = 0; jp < 5; ++jp) {
            const int kb0 = kw0 + 64 * jp;
            if (kb0 + 63 < 0 || kb0 >= SEQ) continue;
            f32x16 S0, S1;
#pragma unroll
            for (int i = 0; i < 16; ++i) { S0[i] = 0.f; S1[i] = 0.f; }
            const LAS bf16* kp0 = Kl + (jp * 64 + r32) * KPITCH + 8 * h;
#pragma unroll
            for (int ks = 0; ks < 4; ++ks) { const bf16x8 k0 = *(const LAS bf16x8*)(kp0 + 16 * ks), k1 = *(const LAS bf16x8*)(kp0 + 32 * KPITCH + 16 * ks);
                S0 = MFMA32(k0, qf[ks], S0); S1 = MFMA32(k1, qf[ks], S1); }
            float tmax = -1e30f;
            const LAS float* bp = bT + kb0;
#pragma unroll
            for (int i = 0; i < 16; ++i) {
                const float l0 = __builtin_fmaf(S0[i], 0.125f * 1.4426950408889634f, bp[(i & 3) + 8 * (i >> 2)]), l1 = __builtin_fmaf(S1[i], 0.125f * 1.4426950408889634f, bp[32 + (i & 3) + 8 * (i >> 2)]);
                S0[i] = l0; S1[i] = l1; tmax = fmaxf(tmax, fmaxf(l0, l1)); }
            tmax = fmaxf(tmax, __shfl_xor(tmax, 32));
            const float mnew = fmaxf(m, tmax), alpha = __builtin_amdgcn_exp2f(m - mnew);
            float psum = 0.f;
#pragma unroll
            for (int i = 0; i < 16; ++i) { const float p0 = __builtin_amdgcn_exp2f(S0[i] - mnew), p1 = __builtin_amdgcn_exp2f(S1[i] - mnew);
                S0[i] = p0; S1[i] = p1; psum += p0 + p1; }
            psum += __shfl_xor(psum, 32);
            lsum = lsum * alpha + psum; m = mnew;
            bf16x8 pf[4];
#pragma unroll
            for (int s2 = 0; s2 < 2; ++s2) { u32x4 p; p.x = pg8::cvt_pk_bf16(S0[8 * s2], S0[8 * s2 + 1]); p.y = pg8::cvt_pk_bf16(S0[8 * s2 + 2], S0[8 * s2 + 3]); p.z = pg8::cvt_pk_bf16(S0[8 * s2 + 4], S0[8 * s2 + 5]); p.w = pg8::cvt_pk_bf16(S0[8 * s2 + 6], S0[8 * s2 + 7]);
                pf[s2] = __builtin_bit_cast(bf16x8, p);
                p.x = pg8::cvt_pk_bf16(S1[8 * s2], S1[8 * s2 + 1]); p.y = pg8::cvt_pk_bf16(S1[8 * s2 + 2], S1[8 * s2 + 3]); p.z = pg8::cvt_pk_bf16(S1[8 * s2 + 4], S1[8 * s2 + 5]); p.w = pg8::cvt_pk_bf16(S1[8 * s2 + 6], S1[8 * s2 + 7]);
                pf[2 + s2] = __builtin_bit_cast(bf16x8, p); }
            const bool resc = __builtin_amdgcn_ballot_w64(alpha != 1.f) != 0;
            const LAS unsigned char* vb = (const LAS unsigned char*)Vl + (jp * 64) * (KPITCH * 2) + trofs;
#pragma unroll
            for (int dt = 0; dt < 2; ++dt) {
                if (resc) {
#pragma unroll
                    for (int i = 0; i < 16; ++i) O[kvh][dt][i] *= alpha; }
#pragma unroll
                for (int s4 = 0; s4 < 4; ++s4) { const bf16x8 vf = vtr8(vb + (16 * s4) * (KPITCH * 2) + dt * 64);
                    O[kvh][dt] = MFMA32(vf, pf[s4], O[kvh][dt]); }
            }
        }
        const float inv = __builtin_amdgcn_rcpf(lsum);
#pragma unroll
        for (int dt = 0; dt < 2; ++dt)
#pragma unroll
            for (int i = 0; i < 16; ++i) O[kvh][dt][i] *= inv;
    }
    const float* gn = a.in[17] + l * 512;
    f32x4 gv[2][2][4];
#pragma unroll
    for (int kvh = 0; kvh < 2; ++kvh)
#pragma unroll
        for (int dt = 0; dt < 2; ++dt)
#pragma unroll
            for (int g4 = 0; g4 < 4; ++g4) gv[kvh][dt][g4] = *(const f32x4*)(gn + (kvh * 4 + hq) * 64 + dt * 32 + 8 * g4 + 4 * h);
    asm volatile("" ::: "memory");
    float ssq = 0.f;
#pragma unroll
    for (int kvh = 0; kvh < 2; ++kvh)
#pragma unroll
        for (int dt = 0; dt < 2; ++dt)
#pragma unroll
            for (int i = 0; i < 16; ++i) ssq += O[kvh][dt][i] * O[kvh][dt][i];
    ssq += __shfl_xor(ssq, 32);
    if (h == 0) red[w * 32 + r32] = ssq;
    __syncthreads();
    const float tot = (red[mt * 32 + r32] + red[(mt + 2) * 32 + r32]) + (red[(mt + 4) * 32 + r32] + red[(mt + 6) * 32 + r32]);
    const float rs = __builtin_amdgcn_rsqf(tot * (1.f / 512.f) + 1e-6f);
    bf16* Y = (bf16*)(a.ws + WS_Y) + (rowb + qpos) * D + 512;
#pragma unroll
    for (int kvh = 0; kvh < 2; ++kvh)
#pragma unroll
        for (int dt = 0; dt < 2; ++dt)
#pragma unroll
            for (int g4 = 0; g4 < 4; ++g4) { const int col = (kvh * 4 + hq) * 64 + dt * 32 + 8 * g4 + 4 * h;
                const f32x4 g = gv[kvh][dt][g4];
                u32x2 o; o.x = pk2(O[kvh][dt][4 * g4] * rs * g.x, O[kvh][dt][4 * g4 + 1] * rs * g.y); o.y = pk2(O[kvh][dt][4 * g4 + 2] * rs * g.z, O[kvh][dt][4 * g4 + 3] * rs * g.w);
                *(u32x2*)(Y + col) = o; }
}

#define XB_TMO      128
#define XB_XCNT(j)  (256  + 64 * (j))
#define XB_XSUB(j)  (1280 + 64 * (j))
#define XB_XGEN(j)  (2304 + 64 * (j))
#define XB_TOP      3328
#define XB_TOPGEN   3392
#define XCD_BAR_WORDS 3456
#define XB_SPIN_CAP (1u << 18)

__device__ __forceinline__ unsigned xb_ld(unsigned* p)              { return __hip_atomic_load(p, __ATOMIC_RELAXED, __HIP_MEMORY_SCOPE_AGENT); }
__device__ __forceinline__ unsigned xb_add(unsigned* p, unsigned v) { return __hip_atomic_fetch_add(p, v, __ATOMIC_RELAXED, __HIP_MEMORY_SCOPE_AGENT); }
__device__ __forceinline__ unsigned xb_xcc_id() { return (unsigned)__builtin_amdgcn_s_getreg((3 << 11) | 20) & 0xFu; }
#define XB_SPIN(cond, bar) do { unsigned _sp = 0; while (cond) { __builtin_amdgcn_s_sleep(1); \
    if ((++_sp & 255u) == 0u) { if (xb_ld(&(bar)[XB_TMO])) break; if (_sp > XB_SPIN_CAP) { atomicAdd(&(bar)[XB_TMO], 1u); break; } } } } while (0)

struct XcdBarrier {
    unsigned* bar; unsigned x;
    volatile LAS unsigned* st;
};

__device__ __forceinline__ XcdBarrier xcd_barrier_post(unsigned* bar, volatile LAS unsigned* st) {
    XcdBarrier b; b.bar = bar; b.x = xb_xcc_id(); b.st = st;
    if (threadIdx.x == 0) (void)xb_add(&bar[XB_XCNT(b.x)], 1u);
    return b;
}
__device__ __forceinline__ void xcd_barrier_complete(unsigned* bar, unsigned x, unsigned& nloc, unsigned& nx) {
    const unsigned G = gridDim.x * gridDim.y * gridDim.z;
    unsigned sum, cnt, mine, sp = 0u;
    for (;;) {
        sum = 0u; cnt = 0u; mine = 0u;
#pragma unroll
        for (unsigned j = 0; j < 16; ++j) { const unsigned c = xb_ld(&bar[XB_XCNT(j)]); sum += c; cnt += (c > 0u) ? 1u : 0u; mine = (j == x) ? c : mine; }
        if (sum == G) break;
        __builtin_amdgcn_s_sleep(1);
        if ((++sp & 255u) == 0u) { if (xb_ld(&bar[XB_TMO])) break; if (sp > XB_SPIN_CAP) { atomicAdd(&bar[XB_TMO], 1u); break; } }
    }
    nloc = mine > 0u ? mine : 1u; nx = cnt > 0u ? cnt : 1u;
}

__device__ __forceinline__ void xcd_barrier(const XcdBarrier& b) {
    asm volatile("s_waitcnt vmcnt(0)" ::: "memory");
    __syncthreads();
    if (threadIdx.x == 0) {
        unsigned* bar = b.bar;
        __builtin_amdgcn_s_waitcnt(0);
        unsigned nloc = b.st[0], nx = b.st[1];
        if (nloc == 0u) { xcd_barrier_complete(bar, b.x, nloc, nx); b.st[0] = nloc; b.st[1] = nx; }
        const unsigned old = xb_add(&bar[XB_XSUB(b.x)], 1u);
        const unsigned gen = old / nloc;
        if (old + 1u == (gen + 1u) * nloc) {
            __builtin_amdgcn_fence(__ATOMIC_RELEASE, "agent");
            asm volatile("s_waitcnt vmcnt(0)" ::: "memory");
            const unsigned og = xb_add(&bar[XB_TOP], 1u);
            const unsigned tg = og / nx;
            if (og + 1u == (tg + 1u) * nx) xb_add(&bar[XB_TOPGEN], 1u);
            else XB_SPIN(xb_ld(&bar[XB_TOPGEN]) == tg, bar);
            __builtin_amdgcn_fence(__ATOMIC_ACQUIRE, "agent");
            xb_add(&bar[XB_XGEN(b.x)], 1u);
            asm volatile("s_waitcnt vmcnt(0)" ::: "memory");
        } else {
            XB_SPIN(xb_ld(&bar[XB_XGEN(b.x)]) == gen, bar);
            __builtin_amdgcn_fence(__ATOMIC_ACQUIRE, "agent");
            asm volatile("s_waitcnt vmcnt(0)" ::: "memory");
        }
    }
    __syncthreads();
}

__global__ void __launch_bounds__(NTHR, 2) mega_fwd(Args a) {
    extern __shared__ __attribute__((aligned(16))) unsigned char lds_raw[];
    LAS unsigned char* lds = (LAS unsigned char*)lds_raw;
    cg::grid_group grid = cg::this_grid();
    const int G = gridDim.x, bx = blockIdx.x, NGW = G * NWAVES;
    bf16* XB = (bf16*)(a.ws + WS_XB); bf16* HB = (bf16*)(a.ws + WS_H); bf16* PROJ = (bf16*)(a.ws + WS_PROJ); bf16* Y = (bf16*)(a.ws + WS_Y);
    float* SS = (float*)(a.ws + WS_SS);
    grid.sync();
    if (threadIdx.x < 2) ((volatile LAS unsigned*)(lds + 131072))[threadIdx.x] = 0u;
    for (int i = threadIdx.x; i < 8 * 384; i += NTHR) {
        const int hh = i / 384, rel = i % 384 - 192, n = rel < 0 ? -rel : rel; int bk = rel > 0 ? 16 : 0;
        if (n < 8) bk += n; else { int k = 8 + (31 - __builtin_clz(n * n)) - 6; bk += k < 15 ? k : 15; }
        ((LAS float*)(lds + LDS_BTAB))[i] = n <= 128 ? a.in[15][bk * 8 + hh] * 1.4426950408889634f : -1e30f; }
    __syncthreads();
    const XcdBarrier xbar = xcd_barrier_post((unsigned*)a.ws, (volatile LAS unsigned*)(lds + 131072));
#define GSYNC() do { _Pragma("unroll 1") for (int sy_ = 0; sy_ < PROBE_SYNCREP; ++sy_) xcd_barrier(xbar); } while (0)

#pragma unroll 1
    for (int rep = 0; rep < PROBE_PROREP; ++rep)
    { int tid_ = threadIdx.x; asm volatile("" : "+v"(tid_)); const int lane = tid_ & 63, wave = __builtin_amdgcn_readfirstlane(tid_ >> 6);
      convert_items(a, lds, 0, 0, 2 * I_G, bx * NWAVES + wave, NGW, wave, lane);
      x_prologue(a, bx * NWAVES + wave, NGW, lane); }
    GSYNC();
    for (int l = 0; l < DEPTH; ++l) {
        const bf16* wl = (const bf16*)(a.ws + WS_W) + (size_t)l * W_LAYER;
#pragma unroll 1
        for (int f = 0; f < 2; ++f) {
            if (f == 1) {
                { pg8::Gemm g{XB, wl + W_IN, T, DIN, D}; pg8::StaticOrder S; S.init(T, DIN, G, bx); pg8::EpiProj E{PROJ, SS};
                  pg8::gemm_phase<pg8::EpiProj, pg8::StaticOrder, true, true>(lds, g, S, E); }
                GSYNC();
#pragma unroll 1
                for (int rep = 0; rep < PROBE_MIXREP; ++rep) {
#pragma unroll 1
                for (int u = bx; u < 256 + NB * NCH; u += G) {
                    __syncthreads();
                    if (u < 256) { _Pragma("unroll 1") for (int rp = 0; rp < PROBE_ATTNREP; ++rp) { attn_unit(a, l, u >> 6, u & 63, lds); __syncthreads(); } }
                    else { const int v = u - 256; _Pragma("unroll 1") for (int rp = 0; rp < PROBE_D1REP; ++rp) lru_unit<0>(a, l, v / NCH, v % NCH, lds); }
                }
                GSYNC();
                carry_phase(a, bx);
                GSYNC();
                _Pragma("unroll 1") for (int rp = 0; rp < PROBE_D2REP; ++rp) lru_finish3(a, l, bx, G, lds);
                GSYNC();
                }
                { pg8::Gemm g{Y, wl + W_OUT, T, D, D}; pg8::StaticOrder S; S.init(T, D, G, bx); pg8::EpiRes E{XB, SS, 1.0f, (LAS float*)(lds + 131072 + 256)};
                  pg8::gemm_phase<pg8::EpiRes, pg8::StaticOrder, true, true>(lds, g, S, E); }
                GSYNC();
            }
#pragma unroll 1
            for (int rp = 0; rp < PROBE_GUREP; ++rp)
            { pg8::Gemm g{XB, wl + (f ? W_GU2 : W_GU1), T, NGU, D}; pg8::StaticOrder S; S.init(T, NGU, G, bx); pg8::EpiSwiglu E{HB, SS};
              pg8::gemm_phase<pg8::EpiSwiglu, pg8::StaticOrder, true, true>(lds, g, S, E); }
            { const int first = ((T / 256) * (NGU / 256)) % G, nidle = G - first;
              const int cl = f ? l + 1 : l, lo = f ? 0 : (l == 0 ? 2 * I_G : PER / 2), hi = f ? PER / 2 : PER;
              if (cl < DEPTH && bx >= first) { int tid_ = threadIdx.x; asm volatile("" : "+v"(tid_)); const int lane = tid_ & 63, wave = __builtin_amdgcn_readfirstlane(tid_ >> 6);
                  convert_items(a, lds, cl, lo, hi, (bx - first) * NWAVES + wave, nidle * NWAVES, wave, lane); } }
            GSYNC();
            { pg8::Gemm g{HB, wl + (f ? W_D2 : W_D1), T, D, FF}; pg8::StaticOrder S; S.init(T, D, G, bx); pg8::EpiRes E{XB, SS, 0.5f, (LAS float*)(lds + 131072 + 256)};
              pg8::gemm_phase<pg8::EpiRes, pg8::StaticOrder, true, true>(lds, g, S, E); }
            GSYNC();
        }
    }
    int tid_ = threadIdx.x; asm volatile("" : "+v"(tid_)); const int lane = tid_ & 63, gw = bx * NWAVES + __builtin_amdgcn_readfirstlane(tid_ >> 6);
    const float* gp = a.in[23] + lane * 8;
    const f32x4 g0 = *(const f32x4*)gp, g1 = *(const f32x4*)(gp + 4), g2 = *(const f32x4*)(gp + 512), g3 = *(const f32x4*)(gp + 516);
#pragma unroll 1
    for (int m0 = gw; m0 < T; m0 += 4 * NGW) {
        u32x4 v[4][2];
#pragma unroll
        for (int q = 0; q < 4; ++q) { const int m = m0 + q * NGW, mc = m < T ? m : gw; const u32x4* xr = (const u32x4*)(XB + (size_t)mc * D) + lane; v[q][0] = xr[0]; v[q][1] = xr[64]; }
        asm volatile("" ::: "memory");
#pragma unroll
        for (int q = 0; q < 4; ++q) { const int m = m0 + q * NGW; if (m < T) {
            f32x4 x[4]; float s = 0.f;
#pragma unroll
            for (int j = 0; j < 2; ++j) { const u32x4 o = v[q][j];
                x[2 * j] = (f32x4){__builtin_bit_cast(float, o.x << 16), __builtin_bit_cast(float, o.x & 0xffff0000u), __builtin_bit_cast(float, o.y << 16), __builtin_bit_cast(float, o.y & 0xffff0000u)};
                x[2 * j + 1] = (f32x4){__builtin_bit_cast(float, o.z << 16), __builtin_bit_cast(float, o.z & 0xffff0000u), __builtin_bit_cast(float, o.w << 16), __builtin_bit_cast(float, o.w & 0xffff0000u)}; }
#pragma unroll
            for (int j = 0; j < 4; ++j) s += (x[j].x * x[j].x + x[j].y * x[j].y) + (x[j].z * x[j].z + x[j].w * x[j].w);
            const float rs = __builtin_amdgcn_rsqf(wave_sum(s) * (1.f / D) + 1e-6f);
            float* orow = a.out + (size_t)m * D + lane * 8;
            *(f32x4*)orow = x[0] * rs * g0; *(f32x4*)(orow + 4) = x[1] * rs * g1; *(f32x4*)(orow + 512) = x[2] * rs * g2; *(f32x4*)(orow + 516) = x[3] * rs * g3; } }
    }
}

extern "C" void kernel_launch(void* const* d_in, const int* in_sizes, int n_in, void* d_out, int out_size, void* d_ws, size_t ws_size, hipStream_t stream) {
    static int grid = 0;
    if (grid == 0) {
        if (n_in != 24 || in_sizes[0] != T * D || out_size != T * D || ws_size < WS_END) { fprintf(stderr, "kernel_launch: unexpected shapes (n_in %d, in0 %d, out %d, ws %zu)\n", n_in, n_in > 0 ? in_sizes[0] : -1, out_size, ws_size); grid = -1; return; }
        int dev = 0, cus = 0, per_cu = 0;
        hipGetDevice(&dev); hipDeviceGetAttribute(&cus, hipDeviceAttributeMultiprocessorCount, dev);
        hipFuncSetAttribute((const void*)mega_fwd, hipFuncAttributeMaxDynamicSharedMemorySize, LDS_BYTES);
        hipOccupancyMaxActiveBlocksPerMultiprocessor(&per_cu, (const void*)mega_fwd, NTHR, LDS_BYTES);
        if (per_cu < 1) per_cu = 1;
        (void)hipGetLastError();
        grid = cus * per_cu;
        fprintf(stderr, "kernel_launch: %d CUs x %d = grid %d\n", cus, per_cu, grid);
    }
    if (grid < 0) return;
    Args a{};
    for (int i = 0; i < 24; ++i) a.in[i] = (const float*)d_in[i];
    a.out = (float*)d_out; a.ws = (unsigned char*)d_ws; a.coop = 1; a.pad = 0;
    if (hipMemsetAsync(d_ws, 0, 65536, stream) != hipSuccess) { fprintf(stderr, "kernel_launch: memset of the barrier words failed\n"); return; }
    void* args[] = {&a};
    hipError_t e = hipLaunchCooperativeKernel((const void*)mega_fwd, dim3(grid), dim3(NTHR), args, LDS_BYTES, stream);
    if (e != hipSuccess) fprintf(stderr, "cooperative launch failed: %s (grid %d)\n", hipGetErrorString(e), grid);
}
```
